# Optimizing an MI355X kernel written in HIP

```python
import math
import jax, jax.numpy as jnp
from jax import lax
import numpy as np

D_MODEL = 2048
BATCH = 1
SEQ = 8192
DEPTH = 2

RMS_EPS = 1e-6
S5_GROUP = 16
S5_GROUPS = D_MODEL // S5_GROUP
S5_STATE = 64
S5_DT_MIN = 1e-3
S5_DT_MAX = 1e-1
HEAD_DIM = 128
N_Q_HEADS = D_MODEL // HEAD_DIM
N_KV_HEADS = N_Q_HEADS // 4
GQA_GROUP = N_Q_HEADS // N_KV_HEADS
ROPE_DIM = HEAD_DIM // 4
ROPE_THETA = 500000.0
CMP_BLOCK = 32
CMP_STRIDE = 16
CMP_HIDDEN = 2 * HEAD_DIM
SEL_BLOCK = 64
SEL_TOPK = 16
SEL_LOCAL = 2
WINDOW = 512
Q_BLOCK = 128
N_BRANCH = 3
Q_DIM = N_Q_HEADS * HEAD_DIM
KV_DIM = N_KV_HEADS * HEAD_DIM
NSA_IN = Q_DIM + 6 * KV_DIM + N_BRANCH * N_Q_HEADS
NSA_SPLITS = tuple(Q_DIM + i * KV_DIM for i in range(7))
NEG = -1e30
D_FF = 5632
N_EXPERTS = 8
TOP_K = 2
EXPERT_FF = 5632
MOE_ROW_BLOCK = 256

kernel_name = "hybrid_s5_nsa_moe_trunk"


def rms_norm(x, gain):
    xf = x.astype(jnp.float32)
    y = xf * lax.rsqrt(jnp.mean(xf * xf, axis=-1, keepdims=True) + RMS_EPS)
    return (y * gain.astype(jnp.float32)).astype(x.dtype)


def rope_partial(x, pos):
    half = ROPE_DIM // 2
    inv = jnp.power(ROPE_THETA, -jnp.arange(half, dtype=jnp.float32) / half)
    ang = pos.astype(jnp.float32)[..., None] * inv
    cos = jnp.cos(ang)[:, :, None, :]
    sin = jnp.sin(ang)[:, :, None, :]
    xr = x[..., :ROPE_DIM].astype(jnp.float32)
    x1, x2 = xr[..., :half], xr[..., half:]
    rot = jnp.concatenate([x1 * cos - x2 * sin, x2 * cos + x1 * sin], axis=-1).astype(x.dtype)
    return jnp.concatenate([rot, x[..., ROPE_DIM:]], axis=-1)


def masked_softmax(s, mask):
    sm = jnp.where(mask, s, NEG)
    m = jnp.max(sm, axis=-1, keepdims=True)
    e = jnp.where(mask, jnp.exp(sm - m), 0.0)
    return e / jnp.maximum(jnp.sum(e, axis=-1, keepdims=True), 1e-30)


def _ssm_combine(e1, e2):
    a1r, a1i, b1r, b1i = e1
    a2r, a2i, b2r, b2i = e2
    return (a2r * a1r - a2i * a1i,
            a2r * a1i + a2i * a1r,
            a2r * b1r - a2i * b1i + b2r,
            a2r * b1i + a2i * b1r + b2i)


def s5_mixer(u, a_re, a_im, log_step, b_re, b_im, c_re, c_im, d_skip, w_glu):
    f32 = jnp.float32
    Bsz, L, _ = u.shape
    dt = jnp.exp(log_step.astype(f32))[:, None]
    ar = a_re.astype(f32)
    ai = a_im.astype(f32)
    mag = jnp.exp(ar * dt)
    lb_re = mag * jnp.cos(ai * dt)
    lb_im = mag * jnp.sin(ai * dt)
    den = ar * ar + ai * ai
    nr = lb_re - 1.0
    coef_re = (nr * ar + lb_im * ai) / den
    coef_im = (lb_im * ar - nr * ai) / den
    ug = u.astype(f32).reshape(Bsz, L, S5_GROUPS, S5_GROUP)
    bu_re = jnp.einsum('blgc,gpc->blgp', ug, b_re.astype(f32))
    bu_im = jnp.einsum('blgc,gpc->blgp', ug, b_im.astype(f32))
    x_re = coef_re * bu_re - coef_im * bu_im
    x_im = coef_re * bu_im + coef_im * bu_re
    a_el_re = jnp.broadcast_to(lb_re, x_re.shape)
    a_el_im = jnp.broadcast_to(lb_im, x_re.shape)
    _, _, h_re, h_im = lax.associative_scan(_ssm_combine, (a_el_re, a_el_im, x_re, x_im), axis=1)
    y = (jnp.einsum('blgp,gcp->blgc', h_re, c_re.astype(f32))
         - jnp.einsum('blgp,gcp->blgc', h_im, c_im.astype(f32)))
    y = y.reshape(Bsz, L, D_MODEL) + d_skip.astype(f32) * u.astype(f32)
    g = jax.nn.gelu(y).astype(u.dtype)
    hg = g @ w_glu
    return hg[..., :D_MODEL] * jax.nn.sigmoid(hg[..., D_MODEL:])


def compress_blocks(t, pe, w1, w2):
    Bsz, L, H, hd = t.shape
    nl = CMP_BLOCK // CMP_STRIDE
    n_cmp = L // CMP_STRIDE - nl + 1
    c = t.reshape(Bsz, L // CMP_STRIDE, CMP_STRIDE, H, hd)
    blocks = jnp.concatenate([c[:, m:m + n_cmp] for m in range(nl)], axis=2)
    blocks = blocks + pe[:, None, :].astype(t.dtype)
    flat = blocks.transpose(0, 1, 3, 2, 4).reshape(Bsz, n_cmp, H, CMP_BLOCK * hd)
    return jax.nn.gelu(flat @ w1) @ w2


def nsa_mixer(u, positions, w_in, q_gain, k_gain, pe_k, pe_v, ck_w1, ck_w2, cv_w1, cv_w2, w_out):
    f32 = jnp.float32
    Bsz, L, _ = u.shape
    proj = u @ w_in
    q, kc, vc, ksl, vsl, kw, vw, g = jnp.split(proj, NSA_SPLITS, axis=-1)

    def heads(t, n):
        return t.reshape(Bsz, L, n, HEAD_DIM)

    q = rope_partial(rms_norm(heads(q, N_Q_HEADS), q_gain), positions)
    ksl = rope_partial(rms_norm(heads(ksl, N_KV_HEADS), k_gain[1]), positions)
    kw = rope_partial(rms_norm(heads(kw, N_KV_HEADS), k_gain[2]), positions)
    vsl = heads(vsl, N_KV_HEADS)
    vw = heads(vw, N_KV_HEADS)

    nl = CMP_BLOCK // CMP_STRIDE
    n_cmp = L // CMP_STRIDE - nl + 1
    kcmp = compress_blocks(heads(kc, N_KV_HEADS), pe_k, ck_w1, ck_w2)
    vcmp = compress_blocks(heads(vc, N_KV_HEADS), pe_v, cv_w1, cv_w2)
    pos_cmp = positions[:, CMP_BLOCK - 1::CMP_STRIDE][:, :n_cmp]
    kcmp = rope_partial(rms_norm(kcmp, k_gain[0]), pos_cmp).transpose(0, 2, 1, 3)
    vcmp = vcmp.transpose(0, 2, 1, 3)
    cmp_end = jnp.arange(n_cmp) * CMP_STRIDE + (CMP_BLOCK - 1)

    n_sel = L // SEL_BLOCK
    k_top = min(SEL_TOPK, n_sel)
    ksb = ksl.reshape(Bsz, n_sel, SEL_BLOCK, N_KV_HEADS, HEAD_DIM).transpose(0, 3, 1, 2, 4)
    vsb = vsl.reshape(Bsz, n_sel, SEL_BLOCK, N_KV_HEADS, HEAD_DIM).transpose(0, 3, 1, 2, 4)

    kwp = jnp.pad(kw.transpose(0, 2, 1, 3), ((0, 0), (0, 0), (WINDOW, 0), (0, 0)))
    vwp = jnp.pad(vw.transpose(0, 2, 1, 3), ((0, 0), (0, 0), (WINDOW, 0), (0, 0)))

    qh = q.reshape(Bsz, L, N_KV_HEADS, GQA_GROUP, HEAD_DIM).transpose(0, 2, 3, 1, 4)
    gates = jax.nn.sigmoid(g.astype(f32)).reshape(Bsz, L, N_BRANCH, N_KV_HEADS, GQA_GROUP)
    gates = gates.transpose(2, 0, 3, 4, 1)

    r = SEL_BLOCK // CMP_STRIDE
    pad_right = max(0, r * n_sel + nl - 1 - n_cmp)
    b_ix = jnp.arange(Bsz)[:, None, None, None]
    h_ix = jnp.arange(N_KV_HEADS)[None, :, None, None]
    blk = jnp.arange(n_sel)
    scale = HEAD_DIM ** -0.5

    def q_block(qb):
        t0 = qb * Q_BLOCK
        t_idx = t0 + jnp.arange(Q_BLOCK)
        qi = lax.dynamic_slice_in_dim(qh, t0, Q_BLOCK, axis=3)
        gi = lax.dynamic_slice_in_dim(gates, t0, Q_BLOCK, axis=4)[..., None]

        s_c = jnp.einsum('bhgtd,bhnd->bhgtn', qi, kcmp, preferred_element_type=f32) * scale
        p_c = masked_softmax(s_c, cmp_end[None, :] <= t_idx[:, None])
        o_c = jnp.einsum('bhgtn,bhnd->bhgtd', p_c.astype(vcmp.dtype), vcmp)

        imp = jnp.pad(jnp.sum(p_c, axis=2), ((0, 0), (0, 0), (0, 0), (0, pad_right)))
        p_slc = jnp.zeros(imp.shape[:-1] + (n_sel,), f32)
        for m in range(r):
            for n in range(nl):
                p_slc = p_slc + imp[..., m + n::r][..., :n_sel]
        cur = t_idx // SEL_BLOCK
        dist = cur[:, None] - blk[None, :]
        forced = (blk[None, :] == 0) | ((dist >= 0) & (dist < SEL_LOCAL))
        score = jnp.where(forced, jnp.inf, jnp.where(dist >= 0, p_slc, -jnp.inf))
        _, sel = lax.top_k(score, k_top)

        ks_g = ksb[b_ix, h_ix, sel].reshape(Bsz, N_KV_HEADS, Q_BLOCK, k_top * SEL_BLOCK, HEAD_DIM)
        vs_g = vsb[b_ix, h_ix, sel].reshape(Bsz, N_KV_HEADS, Q_BLOCK, k_top * SEL_BLOCK, HEAD_DIM)
        pos_s = (sel[..., None] * SEL_BLOCK + jnp.arange(SEL_BLOCK)).reshape(Bsz, N_KV_HEADS, Q_BLOCK, -1)
        s_s = jnp.einsum('bhgtd,bhtkd->bhgtk', qi, ks_g, preferred_element_type=f32) * scale
        p_s = masked_softmax(s_s, (pos_s <= t_idx[:, None])[:, :, None])
        o_s = jnp.einsum('bhgtk,bhtkd->bhgtd', p_s.astype(vs_g.dtype), vs_g)

        kwi = lax.dynamic_slice_in_dim(kwp, t0, Q_BLOCK + WINDOW, axis=2)
        vwi = lax.dynamic_slice_in_dim(vwp, t0, Q_BLOCK + WINDOW, axis=2)
        s_pos = t0 - WINDOW + jnp.arange(Q_BLOCK + WINDOW)
        rel = t_idx[:, None] - s_pos[None, :]
        mask_w = (rel >= 0) & (rel < WINDOW) & (s_pos[None, :] >= 0)
        s_w = jnp.einsum('bhgtd,bhsd->bhgts', qi, kwi, preferred_element_type=f32) * scale
        p_w = masked_softmax(s_w, mask_w)
        o_w = jnp.einsum('bhgts,bhsd->bhgtd', p_w.astype(vwi.dtype), vwi)

        return gi[0] * o_c + gi[1] * o_s + gi[2] * o_w

    o = lax.map(q_block, jnp.arange(L // Q_BLOCK))
    o = o.transpose(1, 0, 4, 2, 3, 5).reshape(Bsz, L, Q_DIM)
    return o.astype(u.dtype) @ w_out


def swiglu(u, w_gu, w_down):
    f = w_down.shape[0]
    gu = u @ w_gu
    return (jax.nn.silu(gu[..., :f]) * gu[..., f:]) @ w_down


def moe_ffn(u, w_router, b_router, w_gu, w_down):
    f32 = jnp.float32
    Bsz, L, D = u.shape
    xt = u.reshape(-1, D)
    n_tok = xt.shape[0]
    logits = (xt @ w_router).astype(f32) + b_router.astype(f32)
    top_v, top_e = lax.top_k(logits, TOP_K)
    top_w = jax.nn.softmax(top_v, axis=-1)
    e_flat = top_e.reshape(-1)
    w_flat = top_w.reshape(-1)
    t_flat = jnp.repeat(jnp.arange(n_tok, dtype=jnp.int32), TOP_K)
    order = jnp.argsort(e_flat)
    e_s, t_s, w_s = e_flat[order], t_flat[order], w_flat[order]
    counts = jnp.bincount(e_flat, length=N_EXPERTS)
    start = jnp.cumsum(counts) - counts
    padded = (counts + MOE_ROW_BLOCK - 1) // MOE_ROW_BLOCK * MOE_ROW_BLOCK
    pad_end = jnp.cumsum(padded)
    pad_start = pad_end - padded
    n_assign = n_tok * TOP_K
    dest = pad_start[e_s] + jnp.arange(n_assign) - start[e_s]
    n_rows = n_assign + N_EXPERTS * MOE_ROW_BLOCK
    row_tok = jnp.full((n_rows,), n_tok, jnp.int32).at[dest].set(t_s)
    row_w = jnp.zeros((n_rows,), f32).at[dest].set(w_s)
    n_blk = n_rows // MOE_ROW_BLOCK
    blk_e = jnp.minimum(jnp.searchsorted(pad_end, jnp.arange(n_blk) * MOE_ROW_BLOCK, side='right'),
                        N_EXPERTS - 1)
    x_rows = jnp.concatenate([xt, jnp.zeros((1, D), xt.dtype)], axis=0)[row_tok]
    x_rows = x_rows.reshape(n_blk, MOE_ROW_BLOCK, D)

    def expert_rows(args):
        xb, e = args
        gu = xb @ w_gu[e]
        return (jax.nn.silu(gu[:, :EXPERT_FF]) * gu[:, EXPERT_FF:]) @ w_down[e]

    out = lax.map(expert_rows, (x_rows, blk_e)).reshape(n_rows, D)
    y = jnp.zeros((n_tok + 1, D), f32).at[row_tok].add(out.astype(f32) * row_w[:, None])[:n_tok]
    return y.reshape(Bsz, L, D).astype(u.dtype)


def setup_inputs(seed: int = 0) -> dict:
    key = jax.random.key(seed)
    keys = jax.random.split(key, 32)
    f32 = jnp.float32
    n_even = (DEPTH + 1) // 2
    n_odd = DEPTH // 2

    def nrm(i, shape, scale):
        return jax.random.normal(keys[i], shape, f32) * scale

    x = nrm(0, (BATCH, SEQ, D_MODEL), 1.0)
    positions = jnp.tile(jnp.arange(SEQ, dtype=jnp.int32)[None, :], (BATCH, 1))
    norm_mix = 1.0 + nrm(1, (DEPTH, D_MODEL), 0.02)
    norm_ffn = 1.0 + nrm(2, (DEPTH, D_MODEL), 0.02)
    n_idx = jnp.arange(S5_STATE, dtype=f32)
    s5_a_re = -0.5 + nrm(3, (n_even, S5_GROUPS, S5_STATE), 0.01)
    s5_a_im = math.pi * n_idx + nrm(4, (n_even, S5_GROUPS, S5_STATE), 0.01)
    s5_log_step = jax.random.uniform(keys[5], (n_even, S5_GROUPS), f32,
                                     math.log(S5_DT_MIN), math.log(S5_DT_MAX))
    s5_b_re = nrm(6, (n_even, S5_GROUPS, S5_STATE, S5_GROUP), (2 * S5_GROUP) ** -0.5)
    s5_b_im = nrm(7, (n_even, S5_GROUPS, S5_STATE, S5_GROUP), (2 * S5_GROUP) ** -0.5)
    s5_c_re = nrm(8, (n_even, S5_GROUPS, S5_GROUP, S5_STATE), S5_STATE ** -0.5)
    s5_c_im = nrm(9, (n_even, S5_GROUPS, S5_GROUP, S5_STATE), S5_STATE ** -0.5)
    s5_d = nrm(10, (n_even, D_MODEL), 1.0)
    s5_w_glu = nrm(11, (n_even, D_MODEL, 2 * D_MODEL), D_MODEL ** -0.5)
    nsa_w_in = nrm(12, (n_odd, D_MODEL, NSA_IN), D_MODEL ** -0.5)
    nsa_q_gain = 1.0 + nrm(13, (n_odd, HEAD_DIM), 0.02)
    nsa_k_gain = 1.0 + nrm(14, (n_odd, N_BRANCH, HEAD_DIM), 0.02)
    nsa_pe_k = nrm(15, (n_odd, CMP_BLOCK, HEAD_DIM), 0.1)
    nsa_pe_v = nrm(16, (n_odd, CMP_BLOCK, HEAD_DIM), 0.1)
    nsa_ck_w1 = nrm(17, (n_odd, CMP_BLOCK * HEAD_DIM, CMP_HIDDEN), (CMP_BLOCK * HEAD_DIM) ** -0.5)
    nsa_ck_w2 = nrm(18, (n_odd, CMP_HIDDEN, HEAD_DIM), CMP_HIDDEN ** -0.5)
    nsa_cv_w1 = nrm(19, (n_odd, CMP_BLOCK * HEAD_DIM, CMP_HIDDEN), (CMP_BLOCK * HEAD_DIM) ** -0.5)
    nsa_cv_w2 = nrm(20, (n_odd, CMP_HIDDEN, HEAD_DIM), CMP_HIDDEN ** -0.5)
    nsa_w_out = nrm(21, (n_odd, Q_DIM, D_MODEL), Q_DIM ** -0.5)
    ffn_w_gu = nrm(22, (n_even, D_MODEL, 2 * D_FF), D_MODEL ** -0.5)
    ffn_w_down = nrm(23, (n_even, D_FF, D_MODEL), D_FF ** -0.5)
    moe_w_router = nrm(24, (n_odd, D_MODEL, N_EXPERTS), D_MODEL ** -0.5)
    moe_b_router = nrm(25, (n_odd, N_EXPERTS), 0.01)
    moe_w_gu = nrm(26, (n_odd, N_EXPERTS, D_MODEL, 2 * EXPERT_FF), D_MODEL ** -0.5)
    moe_w_down = nrm(27, (n_odd, N_EXPERTS, EXPERT_FF, D_MODEL), EXPERT_FF ** -0.5)
    return {"x": x, "positions": positions, "norm_mix": norm_mix, "norm_ffn": norm_ffn,
            "s5_a_re": s5_a_re, "s5_a_im": s5_a_im, "s5_log_step": s5_log_step,
            "s5_b_re": s5_b_re, "s5_b_im": s5_b_im, "s5_c_re": s5_c_re, "s5_c_im": s5_c_im,
            "s5_d": s5_d, "s5_w_glu": s5_w_glu,
            "nsa_w_in": nsa_w_in, "nsa_q_gain": nsa_q_gain, "nsa_k_gain": nsa_k_gain,
            "nsa_pe_k": nsa_pe_k, "nsa_pe_v": nsa_pe_v, "nsa_ck_w1": nsa_ck_w1, "nsa_ck_w2": nsa_ck_w2,
            "nsa_cv_w1": nsa_cv_w1, "nsa_cv_w2": nsa_cv_w2, "nsa_w_out": nsa_w_out,
            "ffn_w_gu": ffn_w_gu, "ffn_w_down": ffn_w_down,
            "moe_w_router": moe_w_router, "moe_b_router": moe_b_router,
            "moe_w_gu": moe_w_gu, "moe_w_down": moe_w_down}


def reference(x, positions, norm_mix, norm_ffn,
              s5_a_re, s5_a_im, s5_log_step, s5_b_re, s5_b_im, s5_c_re, s5_c_im, s5_d, s5_w_glu,
              nsa_w_in, nsa_q_gain, nsa_k_gain, nsa_pe_k, nsa_pe_v, nsa_ck_w1, nsa_ck_w2,
              nsa_cv_w1, nsa_cv_w2, nsa_w_out,
              ffn_w_gu, ffn_w_down,
              moe_w_router, moe_b_router, moe_w_gu, moe_w_down):
    h = x
    for i in range(DEPTH):
        j = i // 2
        u = rms_norm(h, norm_mix[i])
        if i % 2 == 0:
            m = s5_mixer(u, s5_a_re[j], s5_a_im[j], s5_log_step[j], s5_b_re[j], s5_b_im[j],
                         s5_c_re[j], s5_c_im[j], s5_d[j], s5_w_glu[j])
        else:
            m = nsa_mixer(u, positions, nsa_w_in[j], nsa_q_gain[j], nsa_k_gain[j], nsa_pe_k[j],
                          nsa_pe_v[j], nsa_ck_w1[j], nsa_ck_w2[j], nsa_cv_w1[j], nsa_cv_w2[j],
                          nsa_w_out[j])
        h = h + m.astype(h.dtype)
        u = rms_norm(h, norm_ffn[i])
        if i % 2 == 0:
            f = swiglu(u, ffn_w_gu[j], ffn_w_down[j])
        else:
            f = moe_ffn(u, moe_w_router[j], moe_b_router[j], moe_w_gu[j], moe_w_down[j])
        h = h + f.astype(h.dtype)
    return h
```

```cpp
#include <hip/hip_runtime.h>
#include <cstdio>
#include <cstdint>

#ifndef MK_N_LAUNCHES
#define MK_N_LAUNCHES 1
#endif
#ifndef MK_LAST_PHASE
#define MK_LAST_PHASE 17
#endif

#define LAS __attribute__((address_space(3)))
typedef unsigned short bf16_t;
typedef short bf16x8 __attribute__((ext_vector_type(8)));
typedef short s16x4 __attribute__((ext_vector_type(4)));
typedef float f32x2 __attribute__((ext_vector_type(2)));
typedef float f32x4 __attribute__((ext_vector_type(4)));
typedef float f32x16 __attribute__((ext_vector_type(16)));
typedef unsigned u32x2 __attribute__((ext_vector_type(2)));
typedef unsigned u32x4 __attribute__((ext_vector_type(4)));
typedef __bf16 bf16x2_t __attribute__((ext_vector_type(2)));

constexpr int L = 8192, D = 2048, DFF = 5632, NE = 8;
constexpr int NSA_N = 5168, NSA_NP = 5376;
constexpr int MAXROWS = NE * L;
constexpr int NCMP = 512;
constexpr float RMS_EPS = 1e-6f;
constexpr float LOG2E = 1.4426950408889634f;
constexpr float QSCALE = 0.08838834764831845f * LOG2E;

constexpr size_t al256(size_t x) { return (x + 255) & ~(size_t)255; }
constexpr size_t WS_CTL   = 0;
constexpr size_t CTL_BYTES = 65536;
constexpr size_t WS_CNT   = WS_CTL + 32768;
constexpr size_t WS_SS1   = CTL_BYTES;
constexpr size_t WS_SS2   = WS_SS1 + al256((L + 1) * 8);
constexpr size_t WS_SS3   = WS_SS2 + al256((L + 1) * 8);
constexpr size_t WS_RSTDX = WS_SS3 + al256((L + 1) * 8);
constexpr size_t WS_LAMB  = WS_RSTDX + al256(L * 4);
constexpr size_t WS_BCT   = WS_LAMB + 128 * 64 * 8;
constexpr size_t WS_CT    = WS_BCT + 128 * 128 * 16 * 2;
constexpr size_t WS_SEND  = WS_CT + 128 * 16 * 128 * 2;
constexpr size_t WS_BIAS1 = WS_SEND + 32 * 128 * 64 * 8;
constexpr size_t WS_GATES = WS_BIAS1 + 2 * 256 * 4;
constexpr size_t WS_TOKE  = WS_GATES + (size_t)L * 48 * 4;
constexpr size_t WS_TOKP  = WS_TOKE + L * 8;
constexpr size_t WS_TOKW  = WS_TOKP + L * 8;
constexpr size_t WS_TOKD  = WS_TOKW + L * 8;
constexpr size_t WS_ROWTOK= WS_TOKD + L * 8;
constexpr size_t WS_ROWW  = WS_ROWTOK + al256(MAXROWS * 4);
constexpr size_t WS_ROWRS = al256(WS_ROWW + MAXROWS * 4);
constexpr size_t WS_WGLU  = al256(WS_ROWRS + MAXROWS * 4);
constexpr size_t WS_WGU   = WS_WGLU + (size_t)4096 * 2048 * 2;
constexpr size_t WS_WDN   = WS_WGU + (size_t)11264 * 2048 * 2;
constexpr size_t WS_WIN   = WS_WDN + (size_t)2048 * 5632 * 2;
constexpr size_t WS_WOUT  = WS_WIN + (size_t)NSA_NP * 2048 * 2;
constexpr size_t WS_CK1   = WS_WOUT + (size_t)2048 * 2048 * 2;
constexpr size_t WS_CV1   = WS_CK1 + (size_t)256 * 4096 * 2;
constexpr size_t WS_MGU   = WS_CV1 + (size_t)256 * 4096 * 2;
constexpr size_t WS_MDN   = WS_MGU + (size_t)8 * 11264 * 2048;
constexpr size_t WS_G     = WS_MDN + (size_t)8 * 2048 * 5632;
constexpr size_t WS_H1    = WS_G + (size_t)L * D * 2;
constexpr size_t WS_H1B   = WS_H1 + (size_t)L * D * 4;
constexpr size_t WS_ACT1  = WS_H1B + (size_t)L * D * 2;
constexpr size_t WS_H2    = WS_ACT1 + (size_t)L * DFF * 2;
constexpr size_t WS_H2B   = WS_H2 + (size_t)L * D * 4;
constexpr size_t WS_PROJ  = WS_H2B + (size_t)L * D * 2;
constexpr size_t WS_QN    = WS_PROJ + (size_t)L * NSA_NP * 2;
constexpr size_t KVH      = (size_t)(L + 16) * 128 * 2;
constexpr size_t WS_KC    = WS_QN + (size_t)L * D * 2;
constexpr size_t WS_VC    = WS_KC + 4 * KVH;
constexpr size_t WS_KSL   = WS_VC + 4 * KVH;
constexpr size_t WS_VSL   = WS_KSL + 4 * KVH;
constexpr size_t WS_KW    = WS_VSL + 4 * KVH;
constexpr size_t WS_VW    = WS_KW + 4 * KVH;
constexpr size_t WS_PART  = WS_VW + 4 * KVH;
constexpr size_t WS_KCMP  = WS_PART + (size_t)2 * 16 * 2048 * 256 * 4;
constexpr size_t WS_VCMP  = WS_KCMP + (size_t)4 * NCMP * 128 * 2;
constexpr size_t WS_O     = WS_VCMP + (size_t)4 * NCMP * 128 * 2;
constexpr size_t WS_H3    = WS_O + (size_t)L * D * 2;
constexpr size_t WS_H3B   = WS_H3 + (size_t)L * D * 4;
constexpr size_t WS_H3F8  = al256(WS_H3B + (size_t)(L + 1) * D * 2);
constexpr size_t WS_H2F8  = al256(WS_H3F8 + (size_t)(L + 1) * D);
constexpr size_t WS_ACT2  = al256(WS_H2F8 + (size_t)L * D);
constexpr size_t WS_YR    = WS_ACT2 + (size_t)MAXROWS * DFF;
constexpr size_t WS_END   = WS_YR + (size_t)MAXROWS * D * 2;

constexpr int LDS_BAR = 0;
constexpr int LDS_TAB = 64;
constexpr int LDS_REG = 256;
constexpr int LDS_BYTES = 152064;

__device__ __forceinline__ unsigned f2bf(float f) { unsigned u = __builtin_bit_cast(unsigned, f); return (u + 0x7fffu + ((u >> 16) & 1u)) >> 16; }
__device__ __forceinline__ unsigned pk2(float lo, float hi) { f32x2 v = {lo, hi}; bf16x2_t b = __builtin_convertvector(v, bf16x2_t); return __builtin_bit_cast(unsigned, b); }
__device__ __forceinline__ float bf2f(unsigned short b) { return __builtin_bit_cast(float, (unsigned)b << 16); }
__device__ __forceinline__ float fexp2(float x) { return __builtin_amdgcn_exp2f(x); }
__device__ __forceinline__ float frcp(float x) { return __builtin_amdgcn_rcpf(x); }
__device__ __forceinline__ float sigmoidf_(float x) { return frcp(1.0f + fexp2(-x * LOG2E)); }
__device__ __forceinline__ float gelu_tanh(float y) { const float z = 0.7978845608028654f * (y + 0.044715f * y * y * y); return y * frcp(1.0f + fexp2(-2.0f * LOG2E * z)); }
__device__ __forceinline__ void sincos_rev(float ang, float& s, float& c) { float rev = ang * 0.15915494309189535f; rev = rev - floorf(rev); s = __builtin_amdgcn_sinf(rev); c = __builtin_amdgcn_cosf(rev); }
__device__ __forceinline__ float wave_sum(float v) {
#pragma unroll
    for (int o = 1; o < 64; o <<= 1) v += __shfl_xor(v, o);
    return v;
}
typedef unsigned long long u64;
typedef int i32x4 __attribute__((ext_vector_type(4)));
typedef int i32x8 __attribute__((ext_vector_type(8)));
constexpr float SC_W = 512.0f, SC_H = 8.0f, SC_A = 4.0f, SC_O = 16.0f, SC_G = 16.0f;
__device__ __forceinline__ u32x2 pack8_fp8(const f32x4 a, const f32x4 b, const float sc) {
    int w0 = 0, w1 = 0;
    w0 = __builtin_amdgcn_cvt_pk_fp8_f32(a[0] * sc, a[1] * sc, w0, false); w0 = __builtin_amdgcn_cvt_pk_fp8_f32(a[2] * sc, a[3] * sc, w0, true);
    w1 = __builtin_amdgcn_cvt_pk_fp8_f32(b[0] * sc, b[1] * sc, w1, false); w1 = __builtin_amdgcn_cvt_pk_fp8_f32(b[2] * sc, b[3] * sc, w1, true);
    return (u32x2){(unsigned)w0, (unsigned)w1};
}
__device__ __forceinline__ void ss_add(u64* p, float ss) { atomicAdd(p, (u64)(ss * 65536.0f + 0.5f)); }
__device__ __forceinline__ float ss_rstd(const u64* p) { return rsqrtf((float)(*p) * (1.0f / 65536.0f / 2048.0f) + 1e-6f); }
__device__ __forceinline__ void cmadd(float lr, float li, float& hr, float& hi, float xr, float xi) {
    float t0, t1, nr, ni;
    asm("v_fma_f32 %0, -%1, %2, %3" : "=v"(t0) : "v"(li), "v"(hi), "v"(xr));
    asm("v_fma_f32 %0, %1, %2, %3" : "=v"(t1) : "v"(li), "v"(hr), "v"(xi));
    asm("v_fma_f32 %0, %1, %2, %3" : "=v"(nr) : "v"(lr), "v"(hr), "v"(t0));
    asm("v_fma_f32 %0, %1, %2, %3" : "=v"(ni) : "v"(lr), "v"(hi), "v"(t1));
    hr = nr; hi = ni;
}
__device__ __forceinline__ int crow(int i, int hh) { return (i & 3) + 8 * (i >> 2) + 4 * hh; }

#define XB_TMO      128
#define XB_XCNT(j)  (256  + 64 * (j))
#define XB_XSUB(j)  (1280 + 64 * (j))
#define XB_XGEN(j)  (2304 + 64 * (j))
#define XB_TOP      3328
#define XB_TOPGEN   3392
#define XCD_BAR_WORDS 3456
#define XB_SPIN_CAP (1u << 18)
__device__ __forceinline__ unsigned xb_ld(unsigned* p)              { return __hip_atomic_load(p, __ATOMIC_RELAXED, __HIP_MEMORY_SCOPE_AGENT); }
__device__ __forceinline__ unsigned xb_add(unsigned* p, unsigned v) { return __hip_atomic_fetch_add(p, v, __ATOMIC_RELAXED, __HIP_MEMORY_SCOPE_AGENT); }
__device__ __forceinline__ unsigned xb_xcc_id() { return (unsigned)__builtin_amdgcn_s_getreg((3 << 11) | 20) & 0xFu; }
#define XB_SPIN(cond, bar) do { unsigned _sp = 0; while (cond) { __builtin_amdgcn_s_sleep(1); \
    if ((++_sp & 255u) == 0u) { if (xb_ld(&(bar)[XB_TMO])) break; if (_sp > XB_SPIN_CAP) { atomicAdd(&(bar)[XB_TMO], 1u); break; } } } } while (0)
struct XcdBarrier { unsigned* bar; unsigned x; volatile LAS unsigned* st; };
__device__ __forceinline__ XcdBarrier xcd_barrier_post(unsigned* bar, volatile LAS unsigned* st) {
    XcdBarrier b; b.bar = bar; b.x = xb_xcc_id(); b.st = st;
    if (threadIdx.x == 0) (void)xb_add(&bar[XB_XCNT(b.x)], 1u);
    return b;
}
__device__ __forceinline__ void xcd_barrier_complete(unsigned* bar, unsigned x, unsigned& nloc, unsigned& nx) {
    const unsigned G = gridDim.x * gridDim.y * gridDim.z;
    unsigned sum, cnt, mine, sp = 0u;
    for (;;) {
        sum = 0u; cnt = 0u; mine = 0u;
#pragma unroll
        for (unsigned j = 0; j < 16; ++j) { const unsigned c = xb_ld(&bar[XB_XCNT(j)]); sum += c; cnt += (c > 0u) ? 1u : 0u; mine = (j == x) ? c : mine; }
        if (sum == G) break;
        __builtin_amdgcn_s_sleep(1);
        if ((++sp & 255u) == 0u) { if (xb_ld(&bar[XB_TMO])) break; if (sp > XB_SPIN_CAP) { atomicAdd(&bar[XB_TMO], 1u); break; } }
    }
    nloc = mine > 0u ? mine : 1u; nx = cnt > 0u ? cnt : 1u;
}
__device__ __forceinline__ void xcd_barrier(const XcdBarrier& b) {
    asm volatile("s_waitcnt vmcnt(0)" ::: "memory");
    __syncthreads();
    if (threadIdx.x == 0) {
        unsigned* bar = b.bar;
        __builtin_amdgcn_s_waitcnt(0);
        unsigned nloc = b.st[0], nx = b.st[1];
        if (nloc == 0u) { xcd_barrier_complete(bar, b.x, nloc, nx); b.st[0] = nloc; b.st[1] = nx; }
        const unsigned old = xb_add(&bar[XB_XSUB(b.x)], 1u);
        const unsigned gen = old / nloc;
        if (old + 1u == (gen + 1u) * nloc) {
            __builtin_amdgcn_fence(__ATOMIC_RELEASE, "agent");
            asm volatile("s_waitcnt vmcnt(0)" ::: "memory");
            const unsigned og = xb_add(&bar[XB_TOP], 1u);
            const unsigned tg = og / nx;
            if (og + 1u == (tg + 1u) * nx) xb_add(&bar[XB_TOPGEN], 1u);
            else XB_SPIN(xb_ld(&bar[XB_TOPGEN]) == tg, bar);
            __builtin_amdgcn_fence(__ATOMIC_ACQUIRE, "agent");
            xb_add(&bar[XB_XGEN(b.x)], 1u);
            asm volatile("s_waitcnt vmcnt(0)" ::: "memory");
        } else {
            XB_SPIN(xb_ld(&bar[XB_XGEN(b.x)]) == gen, bar);
            __builtin_amdgcn_fence(__ATOMIC_ACQUIRE, "agent");
            asm volatile("s_waitcnt vmcnt(0)" ::: "memory");
        }
    }
    __syncthreads();
}

struct Args { const float* in[29]; float* out; unsigned char* ws; int ph_lo, ph_hi; };
struct Ctx {
    const float* in[29]; float* out; unsigned char* ws;
    template <class T> __device__ __forceinline__ T* p(size_t off) const { return (T*)(ws + off); }
};
enum { I_X = 0, I_POS, I_NMIX, I_NFFN, I_ARE, I_AIM, I_LSTEP, I_BRE, I_BIM, I_CRE, I_CIM, I_SD, I_WGLU, I_WIN, I_QG, I_KG, I_PEK, I_PEV, I_CK1, I_CK2, I_CV1, I_CV2,
       I_WOUT, I_FGU, I_FDN, I_WR, I_BR, I_MGU, I_MDN };

namespace pg8 {
constexpr int BM = 256, BK = 64, HALF = 128, HTB = HALF * BK * 2, STAGE_BYTES = 8 * HTB, NXCD = 8, WGM = 8;
__device__ __forceinline__ int lds_byte(int r, int c) { const int st = (r >> 4) * 2 + (c >> 5), rr = r & 15, cc = c & 31, ob = rr * 64 + cc * 2; return st * 1024 + (ob ^ (((ob >> 9) & 1) << 5)); }
__device__ __forceinline__ void stage_rc(int b, int& R, int& C) { const int st = b / 1024, sb = b % 1024, swz = sb ^ (((sb >> 9) & 1) << 5); R = (st >> 1) * 16 + swz / 64; C = (st & 1) * 32 + (swz % 64) / 2; }
__device__ __forceinline__ int perm32(int rho) { const int n = rho >> 4, i = rho & 15; return 8 * (i >> 2) + 4 * n + (i & 3); }
struct Unit { int pm, pn, ax; };

struct StaticOrder {
    int nM, nN, nwg, G, c;
    __device__ __forceinline__ void init(int nM_, int nN_, int G_, int c_) { nM = nM_; nN = nN_; nwg = nM * nN; G = G_; c = c_; }
    __device__ __forceinline__ bool next(int i, Unit& u) const {
        const long Lx = (long)i * G + c; if (Lx >= nwg) return false;
        int wgid = (int)Lx; { const int q = nwg / NXCD, r = nwg % NXCD, xcd = wgid % NXCD, off = wgid / NXCD; wgid = (xcd < r ? xcd * (q + 1) : r * (q + 1) + (xcd - r) * q) + off; }
        const int nig = WGM * nN, gid = wgid / nig, fm = gid * WGM, gsz = (nM - fm) < WGM ? (nM - fm) : WGM;
        u.pm = fm + ((wgid % nig) % gsz); u.pn = (wgid % nig) / gsz; u.ax = 0; return true;
    }
};
struct DenseSched {
    StaticOrder so; const char* A; const char* B; unsigned lda, ldb;
    __device__ __forceinline__ bool next(int i, Unit& u) const { const bool ok = so.next(i, u); u.ax = u.pn; return ok; }
    __device__ __forceinline__ int unit_nt(const Unit&, int nt) const { return nt; }
    __device__ __forceinline__ const char* a_base(const Unit& u) const { return A + (size_t)u.pm * BM * lda; }
    __device__ __forceinline__ const char* b_base(const Unit& u) const { return B + (size_t)u.pn * BM * ldb; }
    __device__ __forceinline__ void a_rows(const Unit&, const int (&R)[2], unsigned (&o)[2][2]) const {
#pragma unroll
        for (int h = 0; h < 2; ++h)
#pragma unroll
            for (int i = 0; i < 2; ++i) o[h][i] = (unsigned)(h * HALF + R[i]) * lda;
    }
};

template <class Epi, class Sched, bool FP8 = false>
__device__ __forceinline__ void gemm_phase(LAS unsigned char* lds, const Sched& S, const Epi& E, const int nt, const unsigned ldb) {
    const int tid = threadIdx.x, wid = __builtin_amdgcn_readfirstlane(tid >> 6), lane = tid & 63, wr = wid >> 2, wc = wid & 3, fr = lane & 15, fq = lane >> 4;
    int R[2], C[2]; unsigned voffB[2];
#pragma unroll
    for (int i = 0; i < 2; ++i) { stage_rc(tid * 16 + i * 8192, R[i], C[i]); const int Rb = (R[i] & ~31) + perm32(R[i] & 31); voffB[i] = (unsigned)Rb * ldb + (unsigned)C[i] * 2u; }
    const size_t kstep = (size_t)(BK * 2);
    const size_t hstepB = (size_t)HALF * ldb;
    const unsigned ldsw = (unsigned)wid * 1024u;
    const int aoff = lds_byte(wr * 64 + fr, fq * 8), boff = lds_byte(wc * 32 + fr, fq * 8);
#define PG8_SA(b, h) (((b) * 2 + (h)) * HTB)
#define PG8_SB(b, h) ((4 + (b) * 2 + (h)) * HTB)
#define PG8_STAGE(bufoff, gbase, v0, v1) do { \
        __builtin_amdgcn_global_load_lds((const unsigned*)((const char*)(gbase) + (v0)), (LAS unsigned*)(lds + (bufoff) + ldsw), 16, 0, 0); \
        __builtin_amdgcn_global_load_lds((const unsigned*)((const char*)(gbase) + (v1)), (LAS unsigned*)(lds + (bufoff) + ldsw + 8192), 16, 0, 0); } while (0)
#define PG8_LD8(p) __builtin_shufflevector(*(const LAS i32x4*)(p), *(const LAS i32x4*)((p) + 1024), 0, 1, 2, 3, 4, 5, 6, 7)
#define PG8_LDA(dst, b, h) do { if constexpr (FP8) { _Pragma("unroll") for (int m = 0; m < 4; ++m) dst##8[m] = PG8_LD8(lds + PG8_SA(b, h) + aoff + m * 2048); } \
        else { _Pragma("unroll") for (int m = 0; m < 4; ++m) _Pragma("unroll") for (int k = 0; k < 2; ++k) dst[m][k] = *(const LAS bf16x8*)(lds + PG8_SA(b, h) + aoff + m * 2048 + k * 1024); } } while (0)
#define PG8_LDB(dst, b, h) do { if constexpr (FP8) { _Pragma("unroll") for (int n = 0; n < 2; ++n) dst##8[n] = PG8_LD8(lds + PG8_SB(b, h) + boff + n * 2048); } \
        else { _Pragma("unroll") for (int n = 0; n < 2; ++n) _Pragma("unroll") for (int k = 0; k < 2; ++k) dst[n][k] = *(const LAS bf16x8*)(lds + PG8_SB(b, h) + boff + n * 2048 + k * 1024); } } while (0)
#define PG8_MMA(ai, bj, At, Bt) do { __builtin_amdgcn_s_setprio(1); _Pragma("unroll") for (int m = 0; m < 4; ++m) _Pragma("unroll") for (int n = 0; n < 2; ++n) { \
        if constexpr (FP8) asm volatile("v_mfma_f32_16x16x128_f8f6f4 %0, %1, %2, %0" : "+v"(acc[ai][bj][m][n]) : "v"(Bt##8[n]), "v"(At##8[m])); \
        else { _Pragma("unroll") for (int k = 0; k < 2; ++k) acc[ai][bj][m][n] = __builtin_amdgcn_mfma_f32_16x16x32_bf16(Bt[n][k], At[m][k], acc[ai][bj][m][n], 0, 0, 0); } } \
        __builtin_amdgcn_s_setprio(0); } while (0)
#define PG8_WAIT_V(n) asm volatile("s_waitcnt vmcnt(" #n ")" ::: "memory")
#define PG8_WAIT_L(n) asm volatile("s_waitcnt lgkmcnt(" #n ")" ::: "memory")
#define PG8_BAR __builtin_amdgcn_s_barrier()
#define PG8_SCHED __builtin_amdgcn_sched_barrier(0)
    Unit cur, nxt; int ui = 0;
    if (!S.next(0, cur)) return;
    Epi Ee = E;
    Ee.pre(cur, wr, fr);
    f32x4 acc[2][2][4][2];
#pragma unroll
    for (int a = 0; a < 2; ++a)
#pragma unroll
        for (int b = 0; b < 2; ++b)
#pragma unroll
            for (int m = 0; m < 4; ++m)
#pragma unroll
                for (int n = 0; n < 2; ++n) acc[a][b][m][n] = (f32x4){0.f, 0.f, 0.f, 0.f};
    bf16x8 At[4][2], B0[2][2], B1[2][2]; i32x8 At8[4], B08[2], B18[2];
    unsigned cv[2][2], nv[2][2];
    S.a_rows(cur, R, cv);
#pragma unroll
    for (int h = 0; h < 2; ++h)
#pragma unroll
        for (int i = 0; i < 2; ++i) cv[h][i] += (unsigned)C[i] * 2u;
    const char* cA = S.a_base(cur); const char* cB = S.b_base(cur);
    PG8_STAGE(PG8_SB(0, 0), cB, voffB[0], voffB[1]); PG8_STAGE(PG8_SB(0, 1), cB + hstepB, voffB[0], voffB[1]); PG8_STAGE(PG8_SA(0, 0), cA, cv[0][0], cv[0][1]); PG8_STAGE(PG8_SA(0, 1), cA, cv[1][0], cv[1][1]);
    if (wr == 1) PG8_BAR;
    PG8_WAIT_V(2); PG8_BAR;
    PG8_STAGE(PG8_SB(1, 0), cB + kstep, voffB[0], voffB[1]); PG8_STAGE(PG8_SA(1, 0), cA + kstep, cv[0][0], cv[0][1]); PG8_STAGE(PG8_SB(1, 1), cB + hstepB + kstep, voffB[0], voffB[1]);
    PG8_WAIT_V(6); PG8_BAR;
    for (;;) {
        const bool has_next = S.next(ui + 1, nxt);
        const char* nA = cA; const char* nB = cB;
#pragma unroll
        for (int h = 0; h < 2; ++h)
#pragma unroll
            for (int i = 0; i < 2; ++i) nv[h][i] = cv[h][i];
        if (has_next) { nA = S.a_base(nxt); nB = S.b_base(nxt); S.a_rows(nxt, R, nv);
#pragma unroll
            for (int h = 0; h < 2; ++h)
#pragma unroll
                for (int i = 0; i < 2; ++i) nv[h][i] += (unsigned)C[i] * 2u; }
        const int ntc = S.unit_nt(cur, nt);
#pragma unroll 1
        for (int t = 0; t < ntc; t += 2) {
            const bool last = (t == ntc - 2);
            const char* a1 = cA + (size_t)(t + 1) * kstep;
            const char* a2 = last ? nA : cA + (size_t)(t + 2) * kstep; const char* b2 = last ? nB : cB + (size_t)(t + 2) * kstep;
            const char* a3 = a2 + kstep; const char* b3 = b2 + kstep;
            const unsigned w00 = last ? nv[0][0] : cv[0][0], w01 = last ? nv[0][1] : cv[0][1], w10 = last ? nv[1][0] : cv[1][0], w11 = last ? nv[1][1] : cv[1][1];
            PG8_LDB(B0, 0, 0); PG8_LDB(B1, 0, 1); PG8_SCHED; PG8_LDA(At, 0, 0); PG8_STAGE(PG8_SA(1, 1), a1, cv[1][0], cv[1][1]);
            PG8_WAIT_V(8); PG8_WAIT_L(0); PG8_BAR; PG8_MMA(0, 0, At, B0); PG8_MMA(0, 1, At, B1); PG8_BAR; PG8_SCHED;
            PG8_LDA(At, 0, 1); PG8_STAGE(PG8_SB(0, 0), b2, voffB[0], voffB[1]); PG8_STAGE(PG8_SB(0, 1), b2 + hstepB, voffB[0], voffB[1]); PG8_STAGE(PG8_SA(0, 0), a2, w00, w01);
            PG8_WAIT_V(8); PG8_WAIT_L(0); PG8_BAR; PG8_MMA(1, 0, At, B0); PG8_MMA(1, 1, At, B1); PG8_BAR; PG8_SCHED;
            PG8_LDB(B0, 1, 0); PG8_LDB(B1, 1, 1); PG8_SCHED; PG8_LDA(At, 1, 0); PG8_STAGE(PG8_SA(0, 1), a2, w10, w11);
            PG8_WAIT_V(8); PG8_WAIT_L(0); PG8_BAR; PG8_MMA(0, 0, At, B0); PG8_MMA(0, 1, At, B1); PG8_BAR; PG8_SCHED;
            PG8_LDA(At, 1, 1); PG8_STAGE(PG8_SB(1, 0), b3, voffB[0], voffB[1]); PG8_STAGE(PG8_SB(1, 1), b3 + hstepB, voffB[0], voffB[1]); PG8_STAGE(PG8_SA(1, 0), a3, w00, w01);
            PG8_WAIT_V(8); PG8_WAIT_L(0); PG8_BAR; PG8_MMA(1, 0, At, B0); PG8_MMA(1, 1, At, B1); PG8_BAR; PG8_SCHED;
        }
        if (wr == 0) PG8_BAR;
        if constexpr (FP8) asm volatile("s_nop 15\n\ts_nop 15" ::: "memory");
        Ee(acc, cur, wr, wc, fr, fq);
        if (!has_next) break;
#pragma unroll
        for (int a = 0; a < 2; ++a)
#pragma unroll
            for (int b = 0; b < 2; ++b)
#pragma unroll
                for (int m = 0; m < 4; ++m)
#pragma unroll
                    for (int n = 0; n < 2; ++n) acc[a][b][m][n] = (f32x4){0.f, 0.f, 0.f, 0.f};
        cur = nxt; cA = nA; cB = nB; ++ui;
        Ee.pre(cur, wr, fr);
#pragma unroll
        for (int h = 0; h < 2; ++h)
#pragma unroll
            for (int i = 0; i < 2; ++i) cv[h][i] = nv[h][i];
        if (wr == 1) PG8_BAR;
    }
    PG8_WAIT_V(0);
    PG8_BAR;
#undef PG8_SA
#undef PG8_SB
#undef PG8_STAGE
#undef PG8_LDA
#undef PG8_LDB
#undef PG8_MMA
#undef PG8_WAIT_V
#undef PG8_WAIT_L
#undef PG8_BAR
#undef PG8_SCHED
}

typedef f32x4 Acc[2][2][4][2];
__device__ __forceinline__ u32x4 pack8(const f32x4 a, const f32x4 b) { u32x4 w; w.x = pk2(a[0], a[1]); w.y = pk2(a[2], a[3]); w.z = pk2(b[0], b[1]); w.w = pk2(b[2], b[3]); return w; }
__device__ __forceinline__ float sumsq8(const f32x4 a, const f32x4 b) { return (a[0] * a[0] + a[1] * a[1]) + (a[2] * a[2] + a[3] * a[3]) + (b[0] * b[0] + b[1] * b[1]) + (b[2] * b[2] + b[3] * b[3]); }

struct EpiGLU {
    __device__ __forceinline__ void pre(const Unit&, int, int) {}
    const float* X; float* H; bf16_t* Hb; u64* SS; float accs;
    __device__ __forceinline__ void operator()(const Acc& acc, const Unit& u, int wr, int wc, int fr, int fq) const {
        const int col = u.pn * 128 + wc * 32 + fq * 8;
#pragma unroll
        for (int ai = 0; ai < 2; ++ai)
#pragma unroll
            for (int m = 0; m < 4; ++m) {
                const int row = u.pm * BM + ai * HALF + wr * 64 + m * 16 + fr; const size_t o = (size_t)row * D + col;
                f32x4 x0 = *(const f32x4*)(X + o), x1 = *(const f32x4*)(X + o + 4), h0, h1;
#pragma unroll
                for (int e = 0; e < 4; ++e) { h0[e] = x0[e] + acc[ai][0][m][0][e] * accs * sigmoidf_(acc[ai][1][m][0][e] * accs); h1[e] = x1[e] + acc[ai][0][m][1][e] * accs * sigmoidf_(acc[ai][1][m][1][e] * accs); }
                *(u32x4*)(Hb + o) = pack8(h0, h1);
                float ss = sumsq8(h0, h1); ss += __shfl_xor(ss, 16); ss += __shfl_xor(ss, 32);
                if (fq == 0) ss_add(SS + row, ss);
            }
    }
};
template <bool GATHER> struct EpiSwiGLU {
    bf16_t* ACT; const u64* SS; const float* rowrs; float accs;
    u64 ssv[GATHER ? 1 : 8]; float rsv[GATHER ? 8 : 1];
    __device__ __forceinline__ void pre(const Unit& u, int wr, int fr) {
#pragma unroll
        for (int ai = 0; ai < 2; ++ai)
#pragma unroll
            for (int m = 0; m < 4; ++m) { const int row = u.pm * BM + ai * HALF + wr * 64 + m * 16 + fr; if constexpr (GATHER) rsv[ai * 4 + m] = rowrs[row]; else ssv[ai * 4 + m] = SS[row]; }
    }
    __device__ __forceinline__ void operator()(const Acc& acc, const Unit& u, int wr, int wc, int fr, int fq) const {
        const int col = (u.ax & 255) * 128 + wc * 32 + fq * 8;
#pragma unroll
        for (int ai = 0; ai < 2; ++ai)
#pragma unroll
            for (int m = 0; m < 4; ++m) {
                const int row = u.pm * BM + ai * HALF + wr * 64 + m * 16 + fr;
                float rs;
                if constexpr (GATHER) rs = rsv[ai * 4 + m] * accs; else rs = rsqrtf((float)ssv[ai * 4 + m] * (1.0f / 65536.0f / 2048.0f) + 1e-6f);
                f32x4 a0, a1;
#pragma unroll
                for (int e = 0; e < 4; ++e) { const float g0 = acc[ai][0][m][0][e] * rs, g1 = acc[ai][0][m][1][e] * rs;
                    a0[e] = g0 * sigmoidf_(g0) * (acc[ai][1][m][0][e] * rs); a1[e] = g1 * sigmoidf_(g1) * (acc[ai][1][m][1][e] * rs); }
                if constexpr (GATHER) *(u32x2*)((unsigned char*)ACT + (size_t)row * DFF + col) = pack8_fp8(a0, a1, SC_A);
                else *(u32x4*)(ACT + (size_t)row * DFF + col) = pack8(a0, a1);
            }
    }
};
struct EpiResid {
    __device__ __forceinline__ void pre(const Unit&, int, int) {}
    const bf16_t* Hin; float* Hout; bf16_t* Hb; u64* SS; unsigned char* H8; float accs;
    __device__ __forceinline__ void operator()(const Acc& acc, const Unit& u, int wr, int wc, int fr, int fq) const {
#pragma unroll
        for (int ai = 0; ai < 2; ++ai)
#pragma unroll
            for (int m = 0; m < 4; ++m) {
                const int row = u.pm * BM + ai * HALF + wr * 64 + m * 16 + fr; float ss = 0.f;
#pragma unroll
                for (int bj = 0; bj < 2; ++bj) { const size_t o = (size_t)row * D + u.pn * BM + bj * HALF + wc * 32 + fq * 8;
                    const u32x4 rb = *(const u32x4*)(Hin + o); f32x4 r0, r1;
#pragma unroll
                    for (int q = 0; q < 2; ++q) { r0[2 * q] = __builtin_bit_cast(float, rb[q] << 16); r0[2 * q + 1] = __builtin_bit_cast(float, rb[q] & 0xffff0000u); r1[2 * q] = __builtin_bit_cast(float, rb[2 + q] << 16); r1[2 * q + 1] = __builtin_bit_cast(float, rb[2 + q] & 0xffff0000u); }
                    const f32x4 h0 = r0 + acc[ai][bj][m][0] * accs, h1 = r1 + acc[ai][bj][m][1] * accs;
                    if (Hout) { *(f32x4*)(Hout + o) = h0; *(f32x4*)(Hout + o + 4) = h1; }
                    *(u32x4*)(Hb + o) = pack8(h0, h1); ss += sumsq8(h0, h1);
                    if (H8) *(u32x2*)(H8 + o) = pack8_fp8(h0, h1, SC_H); }
                ss += __shfl_xor(ss, 16); ss += __shfl_xor(ss, 32);
                if (fq == 0) ss_add(SS + row, ss);
            }
    }
};
struct EpiProj {
    bf16_t* P; const u64* SS; int ldc; float accs; unsigned char* ws;
    u64 ssv[8];
    __device__ __forceinline__ void pre(const Unit& u, int wr, int fr) {
#pragma unroll
        for (int ai = 0; ai < 2; ++ai)
#pragma unroll
            for (int m = 0; m < 4; ++m) ssv[ai * 4 + m] = SS[u.pm * BM + ai * HALF + wr * 64 + m * 16 + fr];
    }
    __device__ __forceinline__ void operator()(const Acc& acc, const Unit& u, int wr, int wc, int fr, int fq) const {
#pragma unroll
        for (int ai = 0; ai < 2; ++ai)
#pragma unroll
            for (int m = 0; m < 4; ++m) {
                const int row = u.pm * BM + ai * HALF + wr * 64 + m * 16 + fr; const float rs = rsqrtf((float)ssv[ai * 4 + m] * (1.0f / 65536.0f / 2048.0f) + 1e-6f) * accs;
#pragma unroll
                for (int bj = 0; bj < 2; ++bj) {
                    const int slot = 2 * u.pn + bj, kind = slot < 16 ? 0 : ((slot - 16) >> 2) + 1;
                    const u32x4 v = pack8(acc[ai][bj][m][0] * rs, acc[ai][bj][m][1] * rs);
                    if (kind == 1 || kind == 2 || kind == 4 || kind == 6) {
                        const size_t base = kind == 1 ? WS_KC : kind == 2 ? WS_VC : kind == 4 ? WS_VSL : WS_VW;
                        *(u32x4*)((bf16_t*)(ws + base + (size_t)((slot - 16) & 3) * KVH) + (size_t)row * 128 + wc * 32 + fq * 8) = v;
                    } else *(u32x4*)(P + (size_t)row * ldc + u.pn * BM + bj * HALF + wc * 32 + fq * 8) = v;
                }
            }
    }
};
struct EpiPart {
    __device__ __forceinline__ void pre(const Unit&, int, int) {}
    float* P;
    __device__ __forceinline__ void operator()(const Acc& acc, const Unit& u, int wr, int wc, int fr, int fq) const {
#pragma unroll
        for (int ai = 0; ai < 2; ++ai)
#pragma unroll
            for (int m = 0; m < 4; ++m) {
                const int row = u.pm * BM + ai * HALF + wr * 64 + m * 16 + fr;
#pragma unroll
                for (int bj = 0; bj < 2; ++bj) *(u32x4*)((bf16_t*)P + ((size_t)u.ax * 2048 + row) * 256 + bj * HALF + wc * 32 + fq * 8) = pack8(acc[ai][bj][m][0], acc[ai][bj][m][1]);
            }
    }
};
struct EpiMoeDown {
    bf16_t* Y; const float* roww; float* part;
    float wv[8];
    __device__ __forceinline__ void pre(const Unit& u, int wr, int fr) {
#pragma unroll
        for (int ai = 0; ai < 2; ++ai)
#pragma unroll
            for (int m = 0; m < 4; ++m) wv[ai * 4 + m] = roww[u.pm * BM + ai * HALF + wr * 64 + m * 16 + fr];
    }
    __device__ __forceinline__ void operator()(const Acc& acc, const Unit& u, int wr, int wc, int fr, int fq) const {
        const int sub = (u.ax >> 8) & 15, pn = u.ax & 255;
        int rbase = wr * 64 + fr; asm volatile("" : "+v"(rbase));
#pragma unroll
        for (int ai = 0; ai < 2; ++ai)
#pragma unroll
            for (int m = 0; m < 4; ++m) {
                const int rl = ai * HALF + m * 16 + rbase, row = u.pm * BM + rl;
                const float w = wv[ai * 4 + m] * (1.0f / (SC_A * SC_W));
                if (sub) {
                    bf16_t* pp = (bf16_t*)part + ((size_t)((sub - 1) * 64 + (u.ax >> 16)) * 256 + rl) * 256;
#pragma unroll
                    for (int bj = 0; bj < 2; ++bj) *(u32x4*)(pp + bj * HALF + wc * 32 + fq * 8) = pack8(acc[ai][bj][m][0] * w, acc[ai][bj][m][1] * w);
                } else {
#pragma unroll
                    for (int bj = 0; bj < 2; ++bj) *(u32x4*)(Y + (size_t)row * D + pn * BM + bj * HALF + wc * 32 + fq * 8) = pack8(acc[ai][bj][m][0] * w, acc[ai][bj][m][1] * w);
                }
            }
    }
};
}

__device__ __forceinline__ void conv_load(const float* __restrict__ W, int Nsrc, int Ndst, int off1, int item, int lane, f32x4 (&v)[8]) {
    const int nblk = Ndst >> 5, kb = item / nblk, nb = item - kb * nblk, k0 = kb * 64, r0 = nb * 32;
    int c0 = r0;
    if (off1) { const int p = r0 >> 8, b = (r0 >> 7) & 1, i = r0 & 127; c0 = b * off1 + 128 * p + i; }
    const int n4 = (lane & 7) * 4;
    const bool ok = (c0 + n4) < Nsrc;
#pragma unroll
    for (int i = 0; i < 8; ++i) { const int kk = 8 * i + (lane >> 3); v[i] = ok ? __builtin_nontemporal_load((const f32x4*)(W + (size_t)(k0 + kk) * Nsrc + c0 + n4)) : (f32x4){0.f, 0.f, 0.f, 0.f}; }
}
template <bool FP8>
__device__ __forceinline__ void conv_store(int K, int Ndst, const float* __restrict__ gain, bf16_t* __restrict__ WT, int item, LAS float* scr, int lane, const f32x4 (&v)[8]) {
    const int nblk = Ndst >> 5, kb = item / nblk, nb = item - kb * nblk, k0 = kb * 64, r0 = nb * 32;
    const int n4 = (lane & 7) * 4;
#pragma unroll
    for (int i = 0; i < 8; ++i) { const int kk = 8 * i + (lane >> 3);
#pragma unroll
        for (int e = 0; e < 4; ++e) scr[kk * 33 + n4 + e] = v[i][e]; }
    __builtin_amdgcn_fence(__ATOMIC_RELEASE, "wavefront"); __builtin_amdgcn_wave_barrier(); __builtin_amdgcn_fence(__ATOMIC_ACQUIRE, "wavefront");
    const int c = lane & 7;
    float gv[8];
#pragma unroll
    for (int j = 0; j < 8; ++j) gv[j] = gain ? gain[k0 + 8 * c + j] : 1.0f;
#pragma unroll
    for (int j = 0; j < 4; ++j) { const int n = (lane >> 3) + 8 * j; const LAS float* s = scr + (8 * c) * 33 + n;
        if constexpr (FP8) { const f32x4 a = {s[0] * gv[0], s[33] * gv[1], s[2 * 33] * gv[2], s[3 * 33] * gv[3]}, b = {s[4 * 33] * gv[4], s[5 * 33] * gv[5], s[6 * 33] * gv[6], s[7 * 33] * gv[7]};
            *(u32x2*)((unsigned char*)WT + (size_t)(r0 + n) * K + k0 + 8 * c) = pack8_fp8(a, b, SC_W); }
        else { u32x4 o; o.x = pk2(s[0] * gv[0], s[33] * gv[1]); o.y = pk2(s[2 * 33] * gv[2], s[3 * 33] * gv[3]); o.z = pk2(s[4 * 33] * gv[4], s[5 * 33] * gv[5]); o.w = pk2(s[6 * 33] * gv[6], s[7 * 33] * gv[7]);
            *(u32x4*)(WT + (size_t)(r0 + n) * K + k0 + 8 * c) = o; } }
    __builtin_amdgcn_fence(__ATOMIC_RELEASE, "wavefront"); __builtin_amdgcn_wave_barrier(); __builtin_amdgcn_fence(__ATOMIC_ACQUIRE, "wavefront");
}
template <bool FP8 = false>
__device__ __forceinline__ void conv_job(const float* W, int K, int Nsrc, int Ndst, int off1, const float* gain, bf16_t* WT, LAS float* scr, int gw, int nw, int lane) {
    const int items = (K >> 6) * (Ndst >> 5);
    if (gw >= items) return;
    f32x4 va[8], vb[8], vc[8];
    conv_load(W, Nsrc, Ndst, off1, gw, lane, va);
    if (gw + nw < items) conv_load(W, Nsrc, Ndst, off1, gw + nw, lane, vb);
    for (int it = gw; it < items; it += 3 * nw) {
        const int i1 = it + nw, i2 = it + 2 * nw, i3 = it + 3 * nw, i4 = it + 4 * nw;
        if (i2 < items) conv_load(W, Nsrc, Ndst, off1, i2, lane, vc);
        conv_store<FP8>(K, Ndst, gain, WT, it, scr, lane, va);
        if (i1 < items) { if (i3 < items) conv_load(W, Nsrc, Ndst, off1, i3, lane, va); conv_store<FP8>(K, Ndst, gain, WT, i1, scr, lane, vb); }
        if (i2 < items) { if (i4 < items) conv_load(W, Nsrc, Ndst, off1, i4, lane, vb); conv_store<FP8>(K, Ndst, gain, WT, i2, scr, lane, vc); }
    }
}

__device__ __forceinline__ void conv8_load(const float* __restrict__ W, int Nsrc, int Ndst, int off1, int item, int lane, f32x4 (&v)[16]) {
    const int nblk = Ndst >> 5, kb = item / nblk, nb = item - kb * nblk, k0 = kb * 128, r0 = nb * 32;
    int c0 = r0;
    if (off1) { const int p = r0 >> 8, b = (r0 >> 7) & 1, i = r0 & 127; c0 = b * off1 + 128 * p + i; }
    const int n4 = (lane & 7) * 4, g = lane >> 3;
#pragma unroll
    for (int i = 0; i < 16; ++i) v[i] = __builtin_nontemporal_load((const f32x4*)(W + (size_t)(k0 + 16 * g + i) * Nsrc + c0 + n4));
}
__device__ __forceinline__ void conv8_store(int K, int Ndst, const float* __restrict__ gain, unsigned char* __restrict__ WT, int item, int lane, const f32x4 (&v)[16]) {
    const int nblk = Ndst >> 5, kb = item / nblk, nb = item - kb * nblk, k0 = kb * 128, r0 = nb * 32;
    const int n4 = (lane & 7) * 4, g = lane >> 3;
    float gv[16];
#pragma unroll
    for (int j = 0; j < 16; ++j) gv[j] = gain ? gain[k0 + 16 * g + j] : 1.0f;
#pragma unroll
    for (int e = 0; e < 4; ++e) {
        const f32x4 a = {v[0][e] * gv[0], v[1][e] * gv[1], v[2][e] * gv[2], v[3][e] * gv[3]}, b = {v[4][e] * gv[4], v[5][e] * gv[5], v[6][e] * gv[6], v[7][e] * gv[7]};
        const f32x4 cc = {v[8][e] * gv[8], v[9][e] * gv[9], v[10][e] * gv[10], v[11][e] * gv[11]}, d = {v[12][e] * gv[12], v[13][e] * gv[13], v[14][e] * gv[14], v[15][e] * gv[15]};
        const u32x2 lo = pack8_fp8(a, b, SC_W), hi = pack8_fp8(cc, d, SC_W);
        *(u32x4*)(WT + (size_t)(r0 + n4 + e) * K + k0 + 16 * g) = (u32x4){lo.x, lo.y, hi.x, hi.y};
    }
}
__device__ __forceinline__ void conv8_job(const float* W, int K, int Nsrc, int Ndst, int off1, const float* gain, unsigned char* WT, int gw, int nw, int lane) {
    const int items = (K >> 7) * (Ndst >> 5);
    if (gw >= items) return;
    f32x4 va[16], vb[16];
    conv8_load(W, Nsrc, Ndst, off1, gw, lane, va);
    for (int it = gw; it < items; it += 2 * nw) {
        const int i1 = it + nw, i2 = it + 2 * nw;
        if (i1 < items) conv8_load(W, Nsrc, Ndst, off1, i1, lane, vb);
        conv8_store(K, Ndst, gain, WT, it, lane, va);
        if (i1 < items) { if (i2 < items) conv8_load(W, Nsrc, Ndst, off1, i2, lane, va); conv8_store(K, Ndst, gain, WT, i1, lane, vb); }
    }
}
__device__ __forceinline__ void late_convert(const Ctx& c, LAS unsigned char* lds, int gw, int nw) {
    const int lane = threadIdx.x & 63, wid = threadIdx.x >> 6;
    LAS float* scr = (LAS float*)(lds + LDS_REG) + wid * (64 * 33);
    conv_job(c.in[I_FDN], 5632, 2048, 2048, 0, nullptr, c.p<bf16_t>(WS_WDN), scr, gw, nw, lane);
    conv_job<true>(c.in[I_WIN], 2048, NSA_N, NSA_NP, 0, c.in[I_NMIX] + D, c.p<bf16_t>(WS_WIN), scr, gw, nw, lane);
    conv_job<true>(c.in[I_WOUT], 2048, 2048, 2048, 0, nullptr, c.p<bf16_t>(WS_WOUT), scr, gw, nw, lane);
    conv_job(c.in[I_CK1], 4096, 256, 256, 0, nullptr, c.p<bf16_t>(WS_CK1), scr, gw, nw, lane);
    conv_job(c.in[I_CV1], 4096, 256, 256, 0, nullptr, c.p<bf16_t>(WS_CV1), scr, gw, nw, lane);
}
__device__ __forceinline__ void p0_prologue(const Ctx& c, LAS unsigned char* lds) {
    const int tid = threadIdx.x, lane = tid & 63, wid = tid >> 6;
    const int gw = blockIdx.x * 8 + wid, nw = gridDim.x * 8;
    const int gt = blockIdx.x * 512 + tid, ntr = gridDim.x * 512;
    for (int i = gt; i < L + 1; i += ntr) { c.p<u64>(WS_SS1)[i] = 0ull; c.p<u64>(WS_SS2)[i] = 0ull; c.p<u64>(WS_SS3)[i] = 0ull; }
    for (int i = gt; i < D / 2; i += ntr) c.p<unsigned>(WS_H3B)[(size_t)L * D / 2 + i] = 0u;
    for (int i = gt; i < D / 4; i += ntr) c.p<unsigned>(WS_H3F8)[(size_t)L * D / 4 + i] = 0u;
    for (int i = gt; i < 8 * 16 * 64; i += ntr) { const int pl = i / (16 * 64), r = i % (16 * 64);
        unsigned* base = (unsigned*)(c.ws + (pl < 4 ? WS_KC + pl * KVH : WS_VC + (pl - 4) * KVH) + (size_t)L * 256); base[r] = 0u; }
    for (int i = gt; i < MAXROWS; i += ntr) { c.p<int>(WS_ROWTOK)[i] = L; c.p<float>(WS_ROWW)[i] = 0.f; c.p<float>(WS_ROWRS)[i] = 0.f; }
    for (int t = gw; t < L; t += 4 * nw) {
        f32x4 v[4][8];
#pragma unroll
        for (int q = 0; q < 4; ++q) { const int tq = t + q * nw; const f32x4* xr = (const f32x4*)(c.in[I_X] + (size_t)(tq < L ? tq : t) * D);
#pragma unroll
            for (int j = 0; j < 8; ++j) v[q][j] = xr[lane + 64 * j]; }
#pragma unroll
        for (int q = 0; q < 4; ++q) { const int tq = t + q * nw; float s = 0.f;
#pragma unroll
            for (int j = 0; j < 8; ++j) s += (v[q][j][0] * v[q][j][0] + v[q][j][1] * v[q][j][1]) + (v[q][j][2] * v[q][j][2] + v[q][j][3] * v[q][j][3]);
            s = wave_sum(s);
            if (lane == 0 && tq < L) c.p<float>(WS_RSTDX)[tq] = rsqrtf(s * (1.0f / D) + RMS_EPS); }
    }
    for (int i = (int)blockIdx.x * 32 + tid; tid < 32 && i < 128 * 64; i += (int)gridDim.x * 32) {
        const int g = i >> 6, p = i & 63;
        const float dt = __expf(c.in[I_LSTEP][g]), ar = c.in[I_ARE][i], ai = c.in[I_AIM][i];
        const float mag = __expf(ar * dt); float sn, cs; sincos_rev(ai * dt, sn, cs);
        const float lbr = mag * cs, lbi = mag * sn, den = ar * ar + ai * ai, nr = lbr - 1.0f;
        const float cre = (nr * ar + lbi * ai) / den, cim = (lbi * ar - nr * ai) / den;
        c.p<f32x2>(WS_LAMB)[i] = (f32x2){lbr, lbi};
        const float* bre = c.in[I_BRE] + (size_t)i * 16; const float* bim = c.in[I_BIM] + (size_t)i * 16;
        bf16_t* bo_re = c.p<bf16_t>(WS_BCT) + ((size_t)g * 128 + p) * 16; bf16_t* bo_im = bo_re + 64 * 16;
#pragma unroll
        for (int k = 0; k < 16; ++k) { bo_re[k] = (bf16_t)f2bf(cre * bre[k] - cim * bim[k]); bo_im[k] = (bf16_t)f2bf(cre * bim[k] + cim * bre[k]); }
        bf16_t* ct = c.p<bf16_t>(WS_CT) + (size_t)g * 16 * 128;
#pragma unroll
        for (int k = 0; k < 16; ++k) { ct[k * 128 + 2 * p] = (bf16_t)f2bf(c.in[I_CRE][((size_t)g * 16 + k) * 64 + p]); ct[k * 128 + 2 * p + 1] = (bf16_t)f2bf(-c.in[I_CIM][((size_t)g * 16 + k) * 64 + p]); }
    }
    for (int job = ((wid + 4) & 7) * (int)gridDim.x + (int)blockIdx.x; job < 256; job += nw) {
        const int kv = job >> 7, k0 = (job & 127) * 32; const float* pe = c.in[kv ? I_PEV : I_PEK] + k0; const float* w1 = c.in[kv ? I_CV1 : I_CK1] + (size_t)k0 * 256 + 4 * lane;
        f32x4 a4 = {0.f, 0.f, 0.f, 0.f};
        f32x4 wrow[32];
#pragma unroll
        for (int r = 0; r < 32; ++r) wrow[r] = *(const f32x4*)(w1 + (size_t)r * 256);
#pragma unroll
        for (int r = 0; r < 32; ++r) a4 = a4 + wrow[r] * pe[r];
        u64* bacc = (u64*)(c.ws + WS_CTL + 16384) + kv * 256 + 4 * lane;
#pragma unroll
        for (int e = 0; e < 4; ++e) atomicAdd(bacc + e, (u64)(long long)((double)a4[e] * 1099511627776.0));
    }
    LAS float* scr = (LAS float*)(lds + LDS_REG) + wid * (64 * 33);
    conv_job<true>(c.in[I_WGLU], 2048, 4096, 4096, 2048, nullptr, c.p<bf16_t>(WS_WGLU), scr, gw, nw, lane);
    conv_job(c.in[I_FGU], 2048, 11264, 11264, 5632, c.in[I_NFFN], c.p<bf16_t>(WS_WGU), scr, gw, nw, lane);
    if (gridDim.x != 256u) late_convert(c, lds, gw, nw);
}


#ifndef MK_DYN_DN
#define MK_DYN_DN 3
#endif
__device__ __forceinline__ void moe_convert(const Ctx& c, LAS unsigned char* lds, int gw, int nw) {
    const int lane = threadIdx.x & 63;
    for (int e = 0; e < NE; ++e) conv8_job(c.in[I_MGU] + (size_t)e * 2048 * 11264, 2048, 11264, 11264, 5632, c.in[I_NFFN] + D, c.ws + WS_MGU + (size_t)e * 11264 * 2048, gw, nw, lane);
    for (int e = 0; e < NE - MK_DYN_DN; ++e) conv8_job(c.in[I_MDN] + (size_t)e * 5632 * 2048, 5632, 2048, 2048, 0, nullptr, c.ws + WS_MDN + (size_t)e * 2048 * 5632, gw, nw, lane);
}

constexpr int CV_GU_ITEMS = (2048 / 128) * (11264 / 32), CV_DN_ITEMS = (5632 / 128) * (2048 / 32), CV_TOTAL = NE * (CV_GU_ITEMS + CV_DN_ITEMS), CV_CH = 4;
static_assert(CV_TOTAL % CV_CH == 0, "conversion chunks");
__device__ __forceinline__ void moe_convert_queue(const Ctx& c) {
    const int lane = threadIdx.x & 63;
    unsigned* ctr = c.p<unsigned>(WS_CNT) + 1088;
    auto pop = [&]() -> int { unsigned v = 0; if (lane == 0) v = atomicAdd(ctr, (unsigned)CV_CH); return (int)v; };
    auto ld = [&](int it, f32x4 (&v)[16]) {
        if (it < NE * CV_GU_ITEMS) { const int e = it / CV_GU_ITEMS, i = it - e * CV_GU_ITEMS; conv8_load(c.in[I_MGU] + (size_t)e * 2048 * 11264, 11264, 11264, 5632, i, lane, v); }
        else { const int j = it - NE * CV_GU_ITEMS, e = j / CV_DN_ITEMS, i = j - e * CV_DN_ITEMS; conv8_load(c.in[I_MDN] + (size_t)e * 5632 * 2048, 2048, 2048, 0, i, lane, v); }
    };
    auto st = [&](int it, const f32x4 (&v)[16]) {
        if (it < NE * CV_GU_ITEMS) { const int e = it / CV_GU_ITEMS, i = it - e * CV_GU_ITEMS; conv8_store(2048, 11264, c.in[I_NFFN] + D, c.ws + WS_MGU + (size_t)e * 11264 * 2048, i, lane, v); }
        else { const int j = it - NE * CV_GU_ITEMS, e = j / CV_DN_ITEMS, i = j - e * CV_DN_ITEMS; conv8_store(5632, 2048, nullptr, c.ws + WS_MDN + (size_t)e * 2048 * 5632, i, lane, v); }
    };
    constexpr int CV_FIRST = NE * CV_GU_ITEMS + (NE - MK_DYN_DN) * CV_DN_ITEMS;
    int base = CV_FIRST + __builtin_amdgcn_readfirstlane(pop());
    if (base >= CV_TOTAL) return;
    int nraw = pop(), pos = 0;
    auto next_item = [&]() -> int { if (pos == CV_CH) { base = CV_FIRST + __builtin_amdgcn_readfirstlane(nraw); pos = 0; if (base < CV_TOTAL) nraw = pop(); } return base < CV_TOTAL ? base + pos++ : CV_TOTAL; };
    f32x4 va[16], vb[16];
    int a = next_item();
    ld(a, va);
    for (;;) {
        const int b = next_item();
        if (b < CV_TOTAL) ld(b, vb);
        st(a, va);
        if (b >= CV_TOTAL) break;
        a = next_item();
        if (a < CV_TOTAL) ld(a, va);
        st(b, vb);
        if (a >= CV_TOTAL) break;
    }
}

constexpr int XS_STRIDE = 132;
constexpr int XR = 68;
template <int PASS>
__device__ __forceinline__ void s5_pass(const Ctx& c, LAS unsigned char* lds) {
    const int tid = threadIdx.x, lane = tid & 63, wid = tid >> 6, hh = lane >> 5, r = lane & 31, l15 = lane & 15, fq = lane >> 4;
    LAS unsigned* Xw = (LAS unsigned*)(lds + LDS_REG) + wid * (32 * XR);
    LAS float* Us = (LAS float*)(lds + LDS_REG + 8 * 32 * XR * 4) + wid * 512;
    const float* X = c.in[I_X]; const float* gain = c.in[I_NMIX]; const float* rstd = c.p<float>(WS_RSTDX);
    for (int item = blockIdx.x * 8 + wid; item < 32 * 128; item += gridDim.x * 8) {
        const int chunk = item >> 7, g = item & 127, t0 = chunk * 256;
        const f32x2 lam = c.p<f32x2>(WS_LAMB)[g * 64 + lane];
        bf16x8 bfr[4];
#pragma unroll
        for (int nb = 0; nb < 4; ++nb) bfr[nb] = *(const bf16x8*)(c.p<bf16_t>(WS_BCT) + ((size_t)g * 128 + 32 * nb + r) * 16 + 8 * hh);
        float g8[8];
#pragma unroll
        for (int j = 0; j < 8; ++j) g8[j] = gain[16 * g + 8 * hh + j];
        bf16x8 cfr[4]; float dsk = 0.f;
        if (PASS == 2) {
#pragma unroll
            for (int ks = 0; ks < 4; ++ks) cfr[ks] = *(const bf16x8*)(c.p<bf16_t>(WS_CT) + ((size_t)g * 16 + l15) * 128 + 32 * ks + 8 * fq);
            dsk = c.in[I_SD][16 * g + l15];
        }
        f32x4 ua[8], ub[8]; float rsa[8];
#pragma unroll
        for (int tile = 0; tile < 8; ++tile) { const size_t o = (size_t)(t0 + 32 * tile + r) * D + 16 * g + 8 * hh; ua[tile] = *(const f32x4*)(X + o); ub[tile] = *(const f32x4*)(X + o + 4); rsa[tile] = rstd[t0 + 32 * tile + r]; }
        float hr = 0.f, hi = 0.f;
        if (PASS == 2 && chunk > 0) {
            const f32x2* se = c.p<f32x2>(WS_SEND) + g * 64 + lane;
            f32x2 sv[31];
#pragma unroll
            for (int j = 0; j < 31; ++j) sv[j] = (j < chunk) ? se[(size_t)j * 128 * 64] : (f32x2){0.f, 0.f};
            float pr = lam[0], pi = lam[1];
#pragma unroll
            for (int q = 0; q < 8; ++q) { const float a = pr * pr - pi * pi, b = 2.f * pr * pi; pr = a; pi = b; }
#pragma unroll
            for (int j = 0; j < 31; ++j) if (j < chunk) cmadd(pr, pi, hr, hi, sv[j][0], sv[j][1]);
        }
#pragma unroll
        for (int tile = 0; tile < 8; ++tile) {
            const int tt = t0 + 32 * tile; const f32x4 u0 = ua[tile], u1 = ub[tile]; const float rs = rsa[tile];
            const f32x4 v0 = {u0[0] * rs * g8[0], u0[1] * rs * g8[1], u0[2] * rs * g8[2], u0[3] * rs * g8[3]}, v1 = {u1[0] * rs * g8[4], u1[1] * rs * g8[5], u1[2] * rs * g8[6], u1[3] * rs * g8[7]};
            u32x4 aw; aw.x = pk2(v0[0], v0[1]); aw.y = pk2(v0[2], v0[3]); aw.z = pk2(v1[0], v1[1]); aw.w = pk2(v1[2], v1[3]);
            if (PASS == 2) { *(LAS f32x4*)(Us + r * 16 + 8 * hh) = v0; *(LAS f32x4*)(Us + r * 16 + 8 * hh + 4) = v1; }
            const bf16x8 af = __builtin_bit_cast(bf16x8, aw);
#pragma unroll
            for (int nbp = 0; nbp < 2; ++nbp) {
                f32x16 z;
#pragma unroll
                for (int i = 0; i < 16; ++i) z[i] = 0.f;
                const f32x16 xre = __builtin_amdgcn_mfma_f32_32x32x16_bf16(af, bfr[nbp], z, 0, 0, 0);
                const f32x16 xim = __builtin_amdgcn_mfma_f32_32x32x16_bf16(af, bfr[nbp + 2], z, 0, 0, 0);
#pragma unroll
                for (int i = 0; i < 16; ++i) Xw[crow(i, hh) * XR + 32 * nbp + r] = pk2(xre[i], xim[i]);
            }
            __builtin_amdgcn_fence(__ATOMIC_RELEASE, "wavefront"); __builtin_amdgcn_wave_barrier(); __builtin_amdgcn_fence(__ATOMIC_ACQUIRE, "wavefront");
#pragma unroll 1
            for (int tb = 0; tb < 32; tb += 8) {
                unsigned xw[8];
#pragma unroll
                for (int q = 0; q < 8; ++q) xw[q] = Xw[(tb + q) * XR + lane];
#pragma unroll
                for (int q = 0; q < 8; ++q) {
                    cmadd(lam[0], lam[1], hr, hi, __builtin_bit_cast(float, xw[q] << 16), __builtin_bit_cast(float, xw[q] & 0xffff0000u));
                    if (PASS == 2) Xw[(tb + q) * XR + lane] = pk2(hr, hi);
                }
            }
            if (PASS == 2) {
                __builtin_amdgcn_fence(__ATOMIC_RELEASE, "wavefront"); __builtin_amdgcn_wave_barrier(); __builtin_amdgcn_fence(__ATOMIC_ACQUIRE, "wavefront");
#pragma unroll
                for (int mb = 0; mb < 2; ++mb) {
                    f32x4 y = {0.f, 0.f, 0.f, 0.f};
#pragma unroll
                    for (int ks = 0; ks < 4; ++ks) { const bf16x8 a = *(const LAS bf16x8*)((const LAS char*)Xw + (16 * mb + l15) * (XR * 4) + (32 * ks + 8 * fq) * 2); y = __builtin_amdgcn_mfma_f32_16x16x32_bf16(a, cfr[ks], y, 0, 0, 0); }
#pragma unroll
                    for (int e = 0; e < 4; ++e) { const int tl = 16 * mb + 4 * fq + e; const size_t o = (size_t)(tt + tl) * D + 16 * g + l15;
                        c.p<unsigned char>(WS_G)[o] = (unsigned char)(__builtin_amdgcn_cvt_pk_fp8_f32(gelu_tanh(y[e] + dsk * Us[tl * 16 + l15]) * SC_G, 0.f, 0, false) & 0xff); }
                }
            }
            __builtin_amdgcn_fence(__ATOMIC_RELEASE, "wavefront"); __builtin_amdgcn_wave_barrier(); __builtin_amdgcn_fence(__ATOMIC_ACQUIRE, "wavefront");
        }
        if (PASS == 1) c.p<f32x2>(WS_SEND)[((size_t)chunk * 128 + g) * 64 + lane] = (f32x2){hr, hi};
    }
}


__device__ __forceinline__ void lds_test(const Ctx& c, LAS unsigned char* lds) {
    const int tid = threadIdx.x, lane = tid & 63, wid = tid >> 6, hh = lane >> 5, r = lane & 31;
    volatile LAS float* Xs = (volatile LAS float*)(lds + LDS_REG) + wid * (32 * XS_STRIDE);
    unsigned bad = 0;
    for (int it = 0; it < 2048; ++it) {
#pragma unroll
        for (int nb = 0; nb < 4; ++nb)
#pragma unroll
            for (int i = 0; i < 16; ++i) { const int row = crow(i, hh), col = 32 * nb + r; Xs[row * XS_STRIDE + col] = (float)(row * 131 + col * 7 + it + blockIdx.x); }
        __builtin_amdgcn_fence(__ATOMIC_RELEASE, "wavefront"); __builtin_amdgcn_wave_barrier(); __builtin_amdgcn_fence(__ATOMIC_ACQUIRE, "wavefront");
        for (int tau = 0; tau < 32; ++tau) {
            const float a = Xs[tau * XS_STRIDE + lane], b = Xs[tau * XS_STRIDE + 64 + lane];
            bad += (a != (float)(tau * 131 + lane * 7 + it + blockIdx.x)) + (b != (float)(tau * 131 + (64 + lane) * 7 + it + blockIdx.x));
        }
        __builtin_amdgcn_fence(__ATOMIC_RELEASE, "wavefront"); __builtin_amdgcn_wave_barrier(); __builtin_amdgcn_fence(__ATOMIC_ACQUIRE, "wavefront");
    }
    if (bad) atomicAdd(c.p<unsigned>(WS_CNT) + 512, bad);
}
__device__ __forceinline__ void p7_postproj(const Ctx& c, int gw, int nw, int tend) {
    const int tid = threadIdx.x, lane = tid & 63, wid = tid >> 6, l16 = lane & 15, sl = lane >> 4;
    const bf16_t* __restrict__ P = c.p<bf16_t>(WS_PROJ); const int* __restrict__ pos = (const int*)c.in[I_POS];
    if (gw >= tend) return;
    float gq[8], gk1[8], gk2[8];
#pragma unroll
    for (int j = 0; j < 8; ++j) { gq[j] = c.in[I_QG][8 * l16 + j]; gk1[j] = c.in[I_KG][128 + 8 * l16 + j]; gk2[j] = c.in[I_KG][256 + 8 * l16 + j]; }
    u32x4 raw[6], nraw[6]; unsigned short graw = 0, ngraw = 0; int pt = 0, npt = 0;
    auto loads = [&](int t, u32x4 (&r)[6], unsigned short& g, int& p) {
#pragma unroll
        for (int q = 0; q < 6; ++q) { const int sq = q < 4 ? q : (q == 4 ? 6 : 8); r[q] = *(const u32x4*)(P + (size_t)t * NSA_NP + (sq * 4 + sl) * 128 + 8 * l16); }
        g = P[(size_t)t * NSA_NP + 5120 + (lane < 48 ? lane : 0)]; p = pos[t];
    };
    loads(gw, raw, graw, pt);
    for (int t = gw; t < tend; t += nw) {
        const bool more = t + nw < tend;
        if (more) loads(t + nw, nraw, ngraw, npt);
        float cs[8], sn[8];
        { const float pf = (float)pt; const int ib = 8 * (l16 & 1);
#pragma unroll
          for (int j = 0; j < 8; ++j) { const float inv = fexp2(-(float)(ib + j) * (18.931568569324174f / 16.0f)); sincos_rev(pf * inv, sn[j], cs[j]); } }
#pragma unroll
        for (int q = 0; q < 6; ++q) {
            float v[8];
#pragma unroll
            for (int j = 0; j < 4; ++j) { v[2 * j] = __builtin_bit_cast(float, raw[q][j] << 16); v[2 * j + 1] = __builtin_bit_cast(float, raw[q][j] & 0xffff0000u); }
            float ss = 0.f;
#pragma unroll
            for (int j = 0; j < 8; ++j) ss += v[j] * v[j];
            ss += __shfl_xor(ss, 1); ss += __shfl_xor(ss, 2); ss += __shfl_xor(ss, 4); ss += __shfl_xor(ss, 8);
            const float rs = rsqrtf(ss * (1.0f / 128.0f) + RMS_EPS);
#pragma unroll
            for (int j = 0; j < 8; ++j) v[j] = v[j] * rs * (q < 4 ? gq[j] : (q == 4 ? gk1[j] : gk2[j]));
            float pv[8];
#pragma unroll
            for (int j = 0; j < 8; ++j) pv[j] = __shfl_xor(v[j], 2);
            if (l16 < 4) {
#pragma unroll
                for (int j = 0; j < 8; ++j) v[j] = (l16 < 2) ? (v[j] * cs[j] - pv[j] * sn[j]) : (v[j] * cs[j] + pv[j] * sn[j]);
            }
            if (q < 4) {
#pragma unroll
                for (int j = 0; j < 8; ++j) v[j] *= QSCALE;
            }
            u32x4 o; o.x = pk2(v[0], v[1]); o.y = pk2(v[2], v[3]); o.z = pk2(v[4], v[5]); o.w = pk2(v[6], v[7]);
            bf16_t* dst = q < 4 ? c.p<bf16_t>(WS_QN) + (size_t)t * D + (q * 4 + sl) * 128 : (bf16_t*)(c.ws + (q == 4 ? WS_KSL : WS_KW) + sl * KVH) + (size_t)t * 128;
            *(u32x4*)(dst + 8 * l16) = o;
        }
        if (lane < 48) c.p<float>(WS_GATES)[(size_t)t * 48 + lane] = sigmoidf_(bf2f(graw));
        if (more) {
#pragma unroll
            for (int q = 0; q < 6; ++q) raw[q] = nraw[q];
            graw = ngraw; pt = npt; }
    }
}

__device__ __forceinline__ void p9_cmpfinish(const Ctx& c, LAS unsigned char* lds) {
    const int tid = threadIdx.x, lane = tid & 63, wid = tid >> 6;
    LAS float* w2l = (LAS float*)(lds + LDS_REG);
    LAS float* hid = (LAS float*)(lds + LDS_REG + 131072) + wid * 256;
    const int* pos = (const int*)c.in[I_POS];
#pragma unroll 1
    for (int kv = 0; kv < 2; ++kv) {
        __syncthreads();
        { const float* w2 = c.in[kv ? I_CV2 : I_CK2];
          f32x4 wq[16];
#pragma unroll
          for (int q = 0; q < 16; ++q) wq[q] = *(const f32x4*)(w2 + (size_t)(tid + 512 * q) * 4);
#pragma unroll
          for (int q = 0; q < 16; ++q) *(LAS f32x4*)(w2l + (tid + 512 * q) * 4) = wq[q]; }
        __syncthreads();
        for (int row = blockIdx.x * 8 + wid; row < 2048; row += gridDim.x * 8) {
            const int h = row >> 9, n = row & 511;
            bf16_t* dst = (kv ? c.p<bf16_t>(WS_VCMP) : c.p<bf16_t>(WS_KCMP)) + ((size_t)h * NCMP + n) * 128;
            if (n == 511) { dst[lane] = 0; dst[lane + 64] = 0; continue; }
            const bf16_t* part = c.p<bf16_t>(WS_PART) + ((size_t)kv * 8 * 2048 + row) * 256 + 4 * lane;
            float a[4];
            { const u64* bacc = (const u64*)(c.ws + WS_CTL + 16384) + kv * 256 + 4 * lane;
#pragma unroll
              for (int q = 0; q < 4; ++q) a[q] = (float)((double)(long long)bacc[q] * (1.0 / 1099511627776.0)); }
            u32x2 pv[8];
#pragma unroll
            for (int kc = 0; kc < 8; ++kc) pv[kc] = *(const u32x2*)(part + (size_t)kc * 2048 * 256);
#pragma unroll
            for (int kc = 0; kc < 8; ++kc) { a[0] += __builtin_bit_cast(float, pv[kc][0] << 16); a[1] += __builtin_bit_cast(float, pv[kc][0] & 0xffff0000u); a[2] += __builtin_bit_cast(float, pv[kc][1] << 16); a[3] += __builtin_bit_cast(float, pv[kc][1] & 0xffff0000u); }
            *(LAS f32x4*)(hid + 4 * lane) = (f32x4){gelu_tanh(a[0]), gelu_tanh(a[1]), gelu_tanh(a[2]), gelu_tanh(a[3])};
            __builtin_amdgcn_fence(__ATOMIC_RELEASE, "wavefront"); __builtin_amdgcn_wave_barrier(); __builtin_amdgcn_fence(__ATOMIC_ACQUIRE, "wavefront");
            float o0 = 0.f, o1 = 0.f;
#pragma unroll 8
            for (int k = 0; k < 256; ++k) { const float hv = hid[k]; o0 += hv * w2l[k * 128 + lane]; o1 += hv * w2l[k * 128 + 64 + lane]; }
            __builtin_amdgcn_fence(__ATOMIC_RELEASE, "wavefront"); __builtin_amdgcn_wave_barrier(); __builtin_amdgcn_fence(__ATOMIC_ACQUIRE, "wavefront");
            if (kv == 0) {
                const float ss = wave_sum(o0 * o0 + o1 * o1); const float rs = rsqrtf(ss * (1.0f / 128.0f) + RMS_EPS);
                o0 = o0 * rs * c.in[I_KG][lane]; o1 = o1 * rs * c.in[I_KG][64 + lane];
                const float pvv = __shfl_xor(o0, 16);
                if (lane < 32) { const float pf = (float)pos[16 * n + 31]; const float inv = fexp2(-(float)(lane & 15) * (18.931568569324174f / 16.0f)); float sn, cs; sincos_rev(pf * inv, sn, cs);
                    o0 = (lane < 16) ? (o0 * cs - pvv * sn) : (o0 * cs + pvv * sn); }
            }
            dst[lane] = (bf16_t)f2bf(o0); dst[lane + 64] = (bf16_t)f2bf(o1);
        }
    }
}

constexpr int AT_STG = 32768, AT_VOF = 16384, AT_SB = 65536, AT_SE = AT_SB + 64 * 132 * 4, AT_SM = AT_SE + 64 * 132 * 4, AT_END = AT_SM + 64 * 16;
static_assert(LDS_REG + AT_END <= LDS_BYTES && 3 * AT_STG <= AT_SM, "attention LDS");
__device__ __forceinline__ int next_bit(unsigned long long lo, unsigned long long hi, int from) {
    if (from < 64) { const unsigned long long x = lo >> from; if (x) return from + __builtin_ctzll(x); from = 64; }
    if (from < 128) { const unsigned long long x = hi >> (from - 64); if (x) return from + __builtin_ctzll(x); }
    return 128;
}
__device__ __forceinline__ bool get_bit(unsigned long long lo, unsigned long long hi, int j) { return (((j < 64 ? lo : hi) >> (j & 63)) & 1ull) != 0ull; }
__device__ __forceinline__ void glds16(const void* gsrc, unsigned lds_dst) { unsigned keep;
    asm volatile("s_mov_b32 %0, m0\n\ts_mov_b32 m0, %2\n\ts_nop 0\n\tglobal_load_lds_dwordx4 %1, off\n\ts_mov_b32 m0, %0" : "=&s"(keep) : "v"(gsrc), "s"(lds_dst) : "memory"); }
template <int SRC, int OP, int NST>
__device__ __forceinline__ void attn_pass(LAS unsigned char* reg, const bf16_t* Kb, const bf16_t* Vb, unsigned long long mlo, unsigned long long mhi, unsigned long long flo, unsigned long long fhi,
                                          const bf16x8 (&qf)[8], int t_row, const unsigned long long smlo, const unsigned long long smhi, float lgs, f32x16 (&acc)[4], float& lsum, int tok_l,
                                          int st0, bool pre, const bf16_t* nK, const bf16_t* nV, int ntile, bool nWithV, int& st_next) {
    const int tid = threadIdx.x, lane = tid & 63, wid = __builtin_amdgcn_readfirstlane(tid >> 6), hh = lane >> 5, r = lane & 31;
    const int blk = (lane >> 4) & 1, q4l = (lane & 15) >> 2, p4 = lane & 3;
    constexpr int IPT = (OP == 1) ? 4 : 2;
    unsigned goK[2];
#pragma unroll
    for (int q = 0; q < 2; ++q) { const int row = 8 * wid + ((lane & 31) >> 2), ch = 4 * (2 * q + (lane >> 5)) + ((lane & 3) ^ ((row >> 2) & 3)); goK[q] = (unsigned)(row * 256 + ch * 16); }
    const unsigned ldsbase = (unsigned)(size_t)reg + (unsigned)(8 * wid) * 256u;
    int kb[2], vb[2];
#pragma unroll
    for (int q = 0; q < 2; ++q) {
        kb[q] = 2048 * (r >> 3) + 64 * (r & 7) + 16 * ((2 * q + hh) ^ ((r >> 2) & 3));
        vb[q] = 2048 * q + 64 * (4 * hh + q4l) + 16 * ((2 * blk + (p4 >> 1)) ^ (2 * q + hh)) + 8 * (p4 & 1);
    }
    auto issue_any = [&](const bf16_t* Kp, const bf16_t* Vp, int jj, int st, bool withV) {
        const char* kp = (const char*)Kp + (size_t)jj * 16384; const unsigned d = ldsbase + (unsigned)st * AT_STG;
        glds16(kp + goK[0], d); glds16(kp + goK[1], d + 1024u);
        if (withV) { const char* vp = (const char*)Vp + (size_t)jj * 16384; glds16(vp + goK[0], d + AT_VOF); glds16(vp + goK[1], d + AT_VOF + 1024u); }
    };
    auto issue = [&](int jj, int st) { issue_any(Kb, Vb, jj, st, OP == 1); };
    st_next = 0;
    int j = next_bit(mlo, mhi, 0);
    if (j >= 128) return;
    int jA = next_bit(mlo, mhi, j + 1), cnt = 0;
    if (!pre) issue(j, st0);
    if (NST == 3 && jA < 128) issue(jA, (st0 + 1) % 3);
    for (;;) {
        if (NST == 3 && jA < 128) { if (IPT == 4) asm volatile("s_waitcnt vmcnt(4)\n\ts_barrier" ::: "memory"); else asm volatile("s_waitcnt vmcnt(2)\n\ts_barrier" ::: "memory"); }
        else asm volatile("s_waitcnt vmcnt(0)\n\ts_barrier" ::: "memory");
        int jB = 128;
        const int st = (NST == 3) ? (st0 + cnt) % 3 : ((st0 + cnt) & 1);
        if (NST == 3) { if (jA < 128) { jB = next_bit(mlo, mhi, jA + 1); if (jB < 128) issue(jB, (st + 2) % 3); } }
        else { if (jA < 128) issue(jA, st ^ 1); }
        if (jA >= 128 && ntile >= 0) { st_next = (NST == 3) ? (st + 1) % 3 : (st ^ 1); issue_any(nK, nV, ntile, st_next, nWithV); }
        const LAS unsigned char* kl = reg + st * AT_STG; const LAS unsigned char* vl = kl + AT_VOF;
        const bool full = get_bit(flo, fhi, j);
        int kmin = 0, kmax = 63;
        if (!full) {
            if (SRC == 0) kmax = ((t_row - 31) >> 4) - 64 * j;
            else if (SRC == 1) kmax = t_row - 64 * j;
            else { kmax = t_row - 64 * j; kmin = t_row - 511 - 64 * j; }
        }
        float lg = lgs;
        if (SRC == 1) { const unsigned long long w = j < 64 ? smlo : smhi; if (!((w >> (j & 63)) & 1ull)) lg = -INFINITY; }
        kmin -= 4 * hh; kmax -= 4 * hh;
#pragma unroll
        for (int cc = 0; cc < 2; ++cc) {
            f32x16 S;
#pragma unroll
            for (int i = 0; i < 16; ++i) S[i] = lg;
#pragma unroll
            for (int ks = 0; ks < 8; ++ks) { const bf16x8 a = *(const LAS bf16x8*)(kl + kb[ks & 1] + 8192 * cc + 512 * (ks >> 1)); S = __builtin_amdgcn_mfma_f32_32x32x16_bf16(a, qf[ks], S, 0, 0, 0); }
            float p[16];
            if (full) {
#pragma unroll
                for (int i = 0; i < 16; ++i) p[i] = fexp2(S[i]);
            } else {
#pragma unroll
                for (int i = 0; i < 16; ++i) { const int kk = 32 * cc + (i & 3) + 8 * (i >> 2); p[i] = (kk >= kmin && kk <= kmax) ? fexp2(S[i]) : 0.f; }
            }
            if (OP == 0 || (OP == 1 && SRC != 0)) {
                float s = 0.f;
#pragma unroll
                for (int i = 0; i < 16; ++i) s += p[i];
                lsum += s;
            }
            if (OP == 1) {
#pragma unroll
                for (int s2 = 0; s2 < 2; ++s2) {
                    u32x4 pw;
#pragma unroll
                    for (int q = 0; q < 4; ++q) pw[q] = pk2(p[8 * s2 + 2 * q], p[8 * s2 + 2 * q + 1]);
                    const bf16x8 pb = __builtin_bit_cast(bf16x8, pw);
#pragma unroll
                    for (int db = 0; db < 4; ++db) {
                        const int vo = 8192 * cc + 4096 * s2 + 512 * db;
                        const s16x4 lo = __builtin_bit_cast(s16x4, __builtin_amdgcn_ds_read_tr16_b64_v4i16((LAS s16x4*)(vl + vb[0] + vo)));
                        const s16x4 hi = __builtin_bit_cast(s16x4, __builtin_amdgcn_ds_read_tr16_b64_v4i16((LAS s16x4*)(vl + vb[1] + vo)));
                        const bf16x8 vf = __builtin_shufflevector(lo, hi, 0, 1, 2, 3, 4, 5, 6, 7);
                        acc[db] = __builtin_amdgcn_mfma_f32_32x32x16_bf16(vf, pb, acc[db], 0, 0, 0);
                    }
                }
            }
            if (OP == 2) {
                LAS float* sb = (LAS float*)(reg + AT_SB) + tok_l * 132; LAS float* se = (LAS float*)(reg + AT_SE) + tok_l * 132;
#pragma unroll
                for (int q = 0; q < 4; ++q) {
                    float e0 = p[4 * q]; float v = e0 + 2.0f * (p[4 * q + 1] + p[4 * q + 2] + p[4 * q + 3]);
                    v += __shfl_xor(v, 1); v += __shfl_xor(v, 2); e0 += __shfl_xor(e0, 1); e0 += __shfl_xor(e0, 2);
                    const int js = 16 * j + 8 * cc + 2 * q + hh;
                    if ((r & 3) == 0) { sb[js] = v; se[js] = e0; }
                }
            }
        }
        if (jA >= 128) break;
        j = jA; jA = (NST == 3) ? jB : next_bit(mlo, mhi, jA + 1); ++cnt;
    }
    asm volatile("s_waitcnt lgkmcnt(0)\n\ts_barrier" ::: "memory");
}

__device__ __forceinline__ void p10_attention(const Ctx& c, LAS unsigned char* lds) {
    LAS unsigned char* reg = lds + LDS_REG;
    const int tid = threadIdx.x, lane = tid & 63, wid = tid >> 6, hh = lane >> 5, r = lane & 31;
    LAS int* qslot = (LAS int*)(lds + LDS_TAB + 112);
    __syncthreads();
    if (tid == 0) *qslot = (int)atomicAdd(c.p<unsigned>(WS_CNT) + 1024, 1u);
    __syncthreads();
    for (;;) {
        {
            const int idx = *qslot;
            if (idx >= 512) break;
            int nidx = 0;
            if (tid == 0) nidx = (int)atomicAdd(c.p<unsigned>(WS_CNT) + 1024, 1u);
            const int U = idx, h = U & 3, tile = 127 - (U >> 2), t0 = tile * 64, cur = tile;
            const int tok_l = 8 * wid + (r >> 2), t_row = t0 + tok_l, head = 4 * h + (r & 3);
            bf16x8 qf[8];
#pragma unroll
            for (int ks = 0; ks < 8; ++ks) qf[ks] = *(const bf16x8*)(c.p<bf16_t>(WS_QN) + (size_t)t_row * D + head * 128 + 16 * ks + 8 * hh);
            const float* gt = c.p<float>(WS_GATES) + (size_t)t_row * 48 + head;
            const float gc = gt[0], gs = gt[16], gw = gt[32];
            const bf16_t* Kc = c.p<bf16_t>(WS_KCMP) + (size_t)h * NCMP * 128; const bf16_t* Vc = c.p<bf16_t>(WS_VCMP) + (size_t)h * NCMP * 128;
            const bf16_t* Ks = (const bf16_t*)(c.ws + WS_KSL + h * KVH); const bf16_t* Vs = (const bf16_t*)(c.ws + WS_VSL + h * KVH);
            const bf16_t* Kw = (const bf16_t*)(c.ws + WS_KW + h * KVH); const bf16_t* Vw = (const bf16_t*)(c.ws + WS_VW + h * KVH);
            f32x16 acc[4];
#pragma unroll
            for (int db = 0; db < 4; ++db)
#pragma unroll
                for (int i = 0; i < 16; ++i) acc[db][i] = 0.f;
            unsigned long long smlo = 0ull, smhi = 0ull;
            const int ntc = (((t0 + 32) >> 4) >> 6) + 1;
            const unsigned long long mclo = (1ull << ntc) - 1ull;
            const int nfc = t0 >= 31 ? ((((t0 - 31) >> 4) + 1) >> 6) : 0;
            const unsigned long long fclo = (1ull << nfc) - 1ull;
            float lc = 0.f, dummy = 0.f;
            int rst = 0;
            attn_pass<0, 0, 2>(reg, Kc, Vc, mclo, 0ull, fclo, 0ull, qf, t_row, smlo, smhi, 0.f, acc, lc, tok_l, 0, false, Kc, Vc, 0, false, rst);
            lc += __shfl_xor(lc, 32);
            const float lg_lc = -__builtin_amdgcn_logf(fmaxf(lc, 1e-30f));
            { const int s0 = rst; attn_pass<0, 2, 2>(reg, Kc, Vc, mclo, 0ull, fclo, 0ull, qf, t_row, smlo, smhi, lg_lc, acc, dummy, tok_l, s0, true, Ks, Vs, 0, true, rst); }
            __syncthreads();
            {
                const int nforced = cur >= 2 ? 3 : cur + 1, nrem = 16 - nforced, ncand = cur - 2 > 0 ? cur - 2 : 0;
                for (int tk = 0; tk < 8; ++tk) {
                    const int tl = 8 * wid + tk;
                    const LAS float* sb = (const LAS float*)(reg + AT_SB) + tl * 132; const LAS float* se = (const LAS float*)(reg + AT_SE) + tl * 132;
                    const int j0 = lane, j1 = lane + 64;
                    const bool c0 = (j0 >= 1) && (j0 <= cur - 2), c1 = (j1 <= cur - 2);
                    float s0 = c0 ? sb[j0] + se[j0 + 1] : -INFINITY;
                    float s1 = c1 ? sb[j1] + (j1 + 1 < 128 ? se[j1 + 1] : 0.f) : -INFINITY;
                    bool selA = false, selB = false;
                    if (ncand <= nrem) { selA = c0; selB = c1; }
                    else {
                        const unsigned u0 = __builtin_bit_cast(unsigned, s0), u1 = __builtin_bit_cast(unsigned, s1);
                        unsigned thr = 0u;
                        for (int b = 30; b >= 0; --b) { const unsigned cand = thr | (1u << b);
                            const int cn = __builtin_popcountll(__ballot(c0 && u0 >= cand)) + __builtin_popcountll(__ballot(c1 && u1 >= cand)); if (cn >= nrem) thr = cand; }
                        const bool g0 = c0 && u0 > thr, g1 = c1 && u1 > thr, e0 = c0 && u0 == thr, e1 = c1 && u1 == thr;
                        const int need = nrem - (__builtin_popcountll(__ballot(g0)) + __builtin_popcountll(__ballot(g1)));
                        const unsigned long long be0 = __ballot(e0), be1 = __ballot(e1), lt = (1ull << lane) - 1ull;
                        const int r0 = __builtin_popcountll(be0 & lt), r1 = __builtin_popcountll(be0) + __builtin_popcountll(be1 & lt);
                        selA = g0 || (e0 && r0 < need); selB = g1 || (e1 && r1 < need);
                    }
                    if (j0 == 0 || j0 == cur || j0 == cur - 1) selA = true;
                    if (j1 == cur || j1 == cur - 1) selB = true;
                    const unsigned long long b0 = __ballot(selA), b1 = __ballot(selB);
                    if (lane == 0) { LAS unsigned* smw = (LAS unsigned*)(reg + AT_SM) + tl * 4; smw[0] = (unsigned)b0; smw[1] = (unsigned)(b0 >> 32); smw[2] = (unsigned)b1; smw[3] = (unsigned)(b1 >> 32); }
                }
            }
            __syncthreads();
            unsigned long long ulo, uhi;
            {
                const LAS unsigned* smw = (const LAS unsigned*)(reg + AT_SM);
                unsigned a0 = smw[lane * 4], a1 = smw[lane * 4 + 1], a2 = smw[lane * 4 + 2], a3 = smw[lane * 4 + 3];
#pragma unroll
                for (int o = 1; o < 64; o <<= 1) { a0 |= __shfl_xor(a0, o); a1 |= __shfl_xor(a1, o); a2 |= __shfl_xor(a2, o); a3 |= __shfl_xor(a3, o); }
                a0 = __builtin_amdgcn_readfirstlane(a0); a1 = __builtin_amdgcn_readfirstlane(a1); a2 = __builtin_amdgcn_readfirstlane(a2); a3 = __builtin_amdgcn_readfirstlane(a3);
                ulo = (unsigned long long)a0 | ((unsigned long long)a1 << 32); uhi = (unsigned long long)a2 | ((unsigned long long)a3 << 32);
                smlo = (unsigned long long)smw[tok_l * 4] | ((unsigned long long)smw[tok_l * 4 + 1] << 32); smhi = (unsigned long long)smw[tok_l * 4 + 2] | ((unsigned long long)smw[tok_l * 4 + 3] << 32);
            }
            __syncthreads();
            unsigned long long fslo, fshi;
            if (cur >= 64) { fslo = ~0ull; fshi = (1ull << (cur - 64)) - 1ull; } else { fslo = (1ull << cur) - 1ull; fshi = 0ull; }
            float ls = 0.f;
            { const int s0 = rst; attn_pass<1, 1, 3>(reg, Ks, Vs, ulo, uhi, fslo, fshi, qf, t_row, smlo, smhi, 0.f, acc, ls, tok_l, s0, true, Kc, Vc, 0, true, rst); }
            ls += __shfl_xor(ls, 32);
            { const float f = gs / fmaxf(ls, 1e-30f);
#pragma unroll
              for (int db = 0; db < 4; ++db) acc[db] = acc[db] * f; }
            const int jlo = cur - 8 > 0 ? cur - 8 : 0;
            { const int s0 = rst; attn_pass<0, 1, 3>(reg, Kc, Vc, mclo, 0ull, fclo, 0ull, qf, t_row, smlo, smhi, lg_lc + __builtin_amdgcn_logf(gc), acc, dummy, tok_l, s0, true, Kw, Vw, jlo, true, rst); }
            unsigned long long mwlo = 0ull, mwhi = 0ull, fwlo = 0ull, fwhi = 0ull;
            for (int jj = jlo; jj <= cur; ++jj) { const bool fl = (jj >= cur - 7) && (jj <= cur - 1);
                if (jj < 64) { mwlo |= 1ull << jj; if (fl) fwlo |= 1ull << jj; } else { mwhi |= 1ull << (jj - 64); if (fl) fwhi |= 1ull << (jj - 64); } }
            f32x4* stash = (f32x4*)(c.ws + WS_PART) + (size_t)blockIdx.x * (16 * 512) + tid;
#pragma unroll
            for (int db = 0; db < 4; ++db)
#pragma unroll
                for (int q = 0; q < 4; ++q) { stash[(db * 4 + q) * 512] = (f32x4){acc[db][4 * q], acc[db][4 * q + 1], acc[db][4 * q + 2], acc[db][4 * q + 3]}; }
#pragma unroll
            for (int db = 0; db < 4; ++db)
#pragma unroll
                for (int i = 0; i < 16; ++i) acc[db][i] = 0.f;
            float lw = 0.f;
            { const int s0 = rst; attn_pass<2, 1, 3>(reg, Kw, Vw, mwlo, mwhi, fwlo, fwhi, qf, t_row, smlo, smhi, 0.f, acc, lw, tok_l, s0, true, Kw, Vw, -1, false, rst); }
            lw += __shfl_xor(lw, 32);
            { const float f = gw / fmaxf(lw, 1e-30f);
#pragma unroll
              for (int db = 0; db < 4; ++db)
#pragma unroll
                  for (int q = 0; q < 4; ++q) { const f32x4 a = stash[(db * 4 + q) * 512];
#pragma unroll
                      for (int e = 0; e < 4; ++e) acc[db][4 * q + e] = a[e] + acc[db][4 * q + e] * f; } }
            unsigned char* orow = c.ws + WS_O + (size_t)t_row * D + head * 128;
#pragma unroll
            for (int db = 0; db < 4; ++db)
#pragma unroll
                for (int q = 0; q < 4; ++q) { int w = 0; w = __builtin_amdgcn_cvt_pk_fp8_f32(acc[db][4 * q] * SC_O, acc[db][4 * q + 1] * SC_O, w, false); w = __builtin_amdgcn_cvt_pk_fp8_f32(acc[db][4 * q + 2] * SC_O, acc[db][4 * q + 3] * SC_O, w, true);
                    *(unsigned*)(orow + 32 * db + 8 * q + 4 * hh) = (unsigned)w; }
            __syncthreads();
            if (tid == 0) *qslot = nidx;
            __syncthreads();
        }
    }
}

__device__ __forceinline__ void p12_router(const Ctx& c, LAS unsigned char* lds) {
    const int tid = threadIdx.x, lane = tid & 63, wid = tid >> 6;
    const bf16_t* H3 = c.p<bf16_t>(WS_H3B); const float* gain = c.in[I_NFFN] + D; const float* wr = c.in[I_WR];
    LAS float* wl = (LAS float*)(lds + LDS_REG);
#pragma unroll
    for (int q = 0; q < D * 2 / 512; ++q) { const int i = tid + 512 * q, k = i >> 1; f32x4 w = *(const f32x4*)(wr + (size_t)i * 4); const float gk = gain[k]; *(LAS f32x4*)(wl + i * 4) = w * gk; }
    __syncthreads();
    int pt = -1, pe0 = 0, pe1 = 0, pp0 = 0, pp1 = 0; float pw0 = 0.f, pw1 = 0.f, prs = 0.f;
    auto flush = [&]() {
        if (lane == 0 && pt >= 0) { const int d0 = pe0 * L + pp0, d1 = pe1 * L + pp1;
            c.p<int>(WS_ROWTOK)[d0] = pt; c.p<int>(WS_ROWTOK)[d1] = pt; c.p<float>(WS_ROWW)[d0] = pw0; c.p<float>(WS_ROWW)[d1] = pw1; c.p<float>(WS_ROWRS)[d0] = prs; c.p<float>(WS_ROWRS)[d1] = prs; c.p<int>(WS_TOKD)[2 * pt] = d0; c.p<int>(WS_TOKD)[2 * pt + 1] = d1; }
    };
    for (int t = blockIdx.x * 8 + wid; t < L; t += gridDim.x * 8) {
        float lg[8];
#pragma unroll
        for (int e = 0; e < 8; ++e) lg[e] = 0.f;
#pragma unroll 16
        for (int i = 0; i < 32; ++i) { const int k = lane + 64 * i; const float hvv = bf2f(H3[(size_t)t * D + k]); const f32x4 w0 = *(const LAS f32x4*)(wl + k * 8), w1 = *(const LAS f32x4*)(wl + k * 8 + 4);
#pragma unroll
            for (int e = 0; e < 4; ++e) { lg[e] += hvv * w0[e]; lg[4 + e] += hvv * w1[e]; } }
        const float rs = ss_rstd(c.p<u64>(WS_SS3) + t);
#pragma unroll
        for (int e = 0; e < 8; ++e) lg[e] = wave_sum(lg[e]) * rs + c.in[I_BR][e];
        if (lane == 0) {
            int e0 = 0; float v0 = lg[0];
#pragma unroll
            for (int e = 1; e < 8; ++e) if (lg[e] > v0) { v0 = lg[e]; e0 = e; }
            int e1 = -1; float v1 = -INFINITY;
#pragma unroll
            for (int e = 0; e < 8; ++e) if (e != e0 && lg[e] > v1) { v1 = lg[e]; e1 = e; }
            const float w0 = 1.0f / (1.0f + __expf(v1 - v0)), w1 = 1.0f - w0;
            unsigned* cnt = c.p<unsigned>(WS_CNT);
            flush();
            pp0 = (int)atomicAdd(cnt + e0 * 64, 1u); pp1 = (int)atomicAdd(cnt + e1 * 64, 1u);
            pt = t; pe0 = e0; pe1 = e1; pw0 = w0; pw1 = w1; prs = rs;
        }
    }
    flush();
}
__device__ __forceinline__ void moe_tables(const Ctx& c, LAS unsigned char* lds) {
    LAS int* tab = (LAS int*)(lds + LDS_TAB);
    if (threadIdx.x == 0) { int s = 0; for (int e = 0; e < NE; ++e) { const int n = (int)((c.p<unsigned>(WS_CNT)[e * 64] + 255u) >> 8); tab[e] = e * (L / 256); tab[8 + e] = n; tab[17 + e] = s; s += n; } tab[16] = s; }
    __syncthreads();
}
__device__ __forceinline__ void p13_scatter(const Ctx& c, LAS unsigned char* lds) {
    const LAS int* tab = (const LAS int*)(lds + LDS_TAB);
    for (int i = blockIdx.x * 512 + threadIdx.x; i < 2 * L; i += gridDim.x * 512) {
        const int e = c.p<int>(WS_TOKE)[i], dest = tab[e] * 256 + c.p<int>(WS_TOKP)[i];
        c.p<int>(WS_ROWTOK)[dest] = i >> 1; c.p<float>(WS_ROWW)[dest] = c.p<float>(WS_TOKW)[i]; c.p<int>(WS_TOKD)[i] = dest;
    }
}
template <bool GATHER> struct MoeSched {
    const LAS int* tab; int npn, G, cidx; const char* A; const char* B; unsigned lda, ldb; size_t bexp; const int* rowtok;
    __device__ __forceinline__ int total() const { return __builtin_amdgcn_readfirstlane(tab[16]) * npn; }
    __device__ __forceinline__ int nfull() const { return GATHER ? (1 << 30) : (total() / G) * G; }
    __device__ __forceinline__ bool split() const { const int r = total() - nfull(); return !GATHER && r > 0 && r * 4 <= G && r <= 64; }
    __device__ __forceinline__ void decode(int Lx, pg8::Unit& u) const {
        int e = 0;
#pragma unroll
        for (int q = 1; q < NE; ++q) if (Lx >= __builtin_amdgcn_readfirstlane(tab[17 + q]) * npn) e = q;
        const int te = __builtin_amdgcn_readfirstlane(tab[e]), nb = __builtin_amdgcn_readfirstlane(tab[8 + e]);
        const int rem = Lx - __builtin_amdgcn_readfirstlane(tab[17 + e]) * npn, pn = rem / nb;
        u.pm = te + (rem - pn * nb); u.pn = e * (npn) + pn; u.ax = pn;
    }
    __device__ __forceinline__ bool next(int i, pg8::Unit& u) const {
        const int Lx = i * G + cidx, tot = total();
        if (!GATHER && split() && Lx >= nfull()) {
            const int r = tot - nfull(), sh = (r * 8 <= G) ? 3 : 2;
            const int q = Lx - nfull(); if (q >= (r << sh)) return false;
            decode(nfull() + (q >> sh), u); u.ax |= ((q & ((1 << sh) - 1)) + 1) << 8 | (sh == 3 ? 1 << 12 : 0) | (q >> sh) << 16; return true;
        }
        if (Lx >= tot) return false;
        decode(Lx, u); return true;
    }
    __device__ __forceinline__ int ksub(const pg8::Unit& u) const { return (u.ax >> 8) & 15; }
    __device__ __forceinline__ int kstart(const pg8::Unit& u) const { const int q = ksub(u); if (q == 0) return 0;
        if (u.ax & (1 << 12)) return q <= 7 ? 6 * (q - 1) : 40;
        return q <= 1 ? 0 : q == 2 ? 12 : q == 3 ? 24 : 34; }
    __device__ __forceinline__ int unit_nt(const pg8::Unit& u, int nt) const { const int q = ksub(u); if (GATHER || q == 0) return nt;
        if (u.ax & (1 << 12)) return q <= 6 ? 6 : 4;
        return q <= 2 ? 12 : 10; }
    __device__ __forceinline__ const char* a_base(const pg8::Unit& u) const { return GATHER ? A : A + (size_t)u.pm * 256 * lda + (size_t)kstart(u) * 128; }
    __device__ __forceinline__ const char* b_base(const pg8::Unit& u) const { return B + (size_t)(u.pn / npn) * bexp + (size_t)(u.ax & 255) * 256 * ldb + (GATHER ? 0 : (size_t)kstart(u) * 128); }
    __device__ __forceinline__ void a_rows(const pg8::Unit& u, const int (&R)[2], unsigned (&o)[2][2]) const {
#pragma unroll
        for (int h = 0; h < 2; ++h)
#pragma unroll
            for (int i = 0; i < 2; ++i) o[h][i] = GATHER ? (unsigned)rowtok[u.pm * 256 + h * 128 + R[i]] * lda : (unsigned)(h * 128 + R[i]) * lda;
    }
};
struct CmpSched {
    int G, cidx; const unsigned char* ws;
    __device__ __forceinline__ int unit_nt(const pg8::Unit&, int nt) const { return nt; }
    __device__ __forceinline__ bool next(int i, pg8::Unit& u) const { const int Lx = i * G + cidx; if (Lx >= 128) return false; u.pm = Lx & 7; u.pn = (Lx >> 3) & 7; u.ax = (Lx >> 6) * 8 + u.pn; return true; }
    __device__ __forceinline__ const char* a_base(const pg8::Unit& u) const { const int kv = u.ax >> 3, h = u.pm >> 1, n0 = (u.pm & 1) * 256;
        return (const char*)ws + (kv ? WS_VC : WS_KC) + h * KVH + (size_t)n0 * 4096 + (size_t)u.pn * 1024; }
    __device__ __forceinline__ const char* b_base(const pg8::Unit& u) const { return (const char*)ws + ((u.ax >> 3) ? WS_CV1 : WS_CK1) + (size_t)u.pn * 1024; }
    __device__ __forceinline__ void a_rows(const pg8::Unit&, const int (&R)[2], unsigned (&o)[2][2]) const {
#pragma unroll
        for (int h = 0; h < 2; ++h)
#pragma unroll
            for (int i = 0; i < 2; ++i) o[h][i] = (unsigned)(h * 128 + R[i]) * 4096u;
    }
};
__device__ __forceinline__ void p16_combine(const Ctx& c, LAS unsigned char* lds) {
    const bf16_t* H3 = c.p<bf16_t>(WS_H3B); const bf16_t* YR = c.p<bf16_t>(WS_YR); const int* td = c.p<int>(WS_TOKD);
    const LAS int* tab = (const LAS int*)(lds + LDS_TAB);
    const int tot = tab[16] * 8, nfull = (tot / (int)gridDim.x) * (int)gridDim.x, rem = tot - nfull; const bool split = rem > 0 && rem * 4 <= (int)gridDim.x && rem <= 64; const int nsp = (rem * 8 <= (int)gridDim.x) ? 8 : 4;
    for (int i = blockIdx.x * 512 + threadIdx.x; i < L * (D / 8); i += gridDim.x * 512) {
        const int t = i >> 8, c8 = (i & 255) * 8, pn = c8 >> 8; const size_t o = (size_t)t * D + c8;
        const u32x4 hb = *(const u32x4*)(H3 + o);
        f32x4 o0 = {__builtin_bit_cast(float, hb[0] << 16), __builtin_bit_cast(float, hb[0] & 0xffff0000u), __builtin_bit_cast(float, hb[1] << 16), __builtin_bit_cast(float, hb[1] & 0xffff0000u)};
        f32x4 o1 = {__builtin_bit_cast(float, hb[2] << 16), __builtin_bit_cast(float, hb[2] & 0xffff0000u), __builtin_bit_cast(float, hb[3] << 16), __builtin_bit_cast(float, hb[3] & 0xffff0000u)};
        const int d0 = td[2 * t], d1 = td[2 * t + 1];
        const u32x4 a = *(const u32x4*)(YR + (size_t)d0 * D + c8), b = *(const u32x4*)(YR + (size_t)d1 * D + c8);
        bool via0 = true, via1 = true;
        if (split) {
#pragma unroll
            for (int k = 0; k < 2; ++k) {
                const int d = k ? d1 : d0, rt = d >> 8, e = rt >> 5, Lu = tab[17 + e] * 8 + pn * tab[8 + e] + (rt & 31);
                if (Lu >= nfull) {
                    if (k) via1 = false; else via0 = false;
#pragma unroll
                    for (int sgm = 0; sgm < 8; ++sgm) { if (sgm >= nsp) break; const u32x4 pv = *(const u32x4*)(c.p<bf16_t>(WS_PART) + ((size_t)(sgm * 64 + (Lu - nfull)) * 256 + (d & 255)) * 256 + (c8 & 255));
#pragma unroll
                        for (int q = 0; q < 2; ++q) { o0[2 * q] += __builtin_bit_cast(float, pv[q] << 16); o0[2 * q + 1] += __builtin_bit_cast(float, pv[q] & 0xffff0000u); o1[2 * q] += __builtin_bit_cast(float, pv[2 + q] << 16); o1[2 * q + 1] += __builtin_bit_cast(float, pv[2 + q] & 0xffff0000u); } }
                }
            }
        }
        if (via0) {
#pragma unroll
            for (int q = 0; q < 2; ++q) { o0[2 * q] += __builtin_bit_cast(float, a[q] << 16); o0[2 * q + 1] += __builtin_bit_cast(float, a[q] & 0xffff0000u); o1[2 * q] += __builtin_bit_cast(float, a[2 + q] << 16); o1[2 * q + 1] += __builtin_bit_cast(float, a[2 + q] & 0xffff0000u); } }
        if (via1) {
#pragma unroll
            for (int q = 0; q < 2; ++q) { o0[2 * q] += __builtin_bit_cast(float, b[q] << 16); o0[2 * q + 1] += __builtin_bit_cast(float, b[q] & 0xffff0000u); o1[2 * q] += __builtin_bit_cast(float, b[2 + q] << 16); o1[2 * q + 1] += __builtin_bit_cast(float, b[2 + q] & 0xffff0000u); } }
        *(f32x4*)(c.out + o) = o0; *(f32x4*)(c.out + o + 4) = o1;
    }
}
__device__ __forceinline__ void copy_out(const Ctx& c, const float* src) {
    for (int i = blockIdx.x * 512 + threadIdx.x; i < L * D / 4; i += gridDim.x * 512) ((f32x4*)c.out)[i] = ((const f32x4*)src)[i];
}


__device__ __forceinline__ void dump_out(const Ctx& c) {
    for (size_t i = (size_t)blockIdx.x * 512 + threadIdx.x; i < (size_t)L * D; i += (size_t)gridDim.x * 512) {
        float v = 0.f;
        if (MK_LAST_PHASE <= 2) {
            if (i < 524288) v = (float)(c.p<unsigned>(WS_SEND)[i] & 0xFFFu);
            else if (i < 524288 + 16384) v = 0.f;
            else if (i < 524288 + 16384 + 8192) v = 0.f;

        } else v = bf2f(c.p<bf16_t>(MK_LAST_PHASE == 3 ? WS_G : MK_LAST_PHASE == 4 ? WS_H1B : MK_LAST_PHASE == 5 ? WS_ACT1 : MK_LAST_PHASE == 6 ? WS_H2B : WS_PROJ)[i]);
        c.out[i] = v;
    }
}
#if defined(__HIP_DEVICE_COMPILE__)
#define MK_NO_PK __attribute__((target("no-packed-fp32-ops")))
#else
#define MK_NO_PK
#endif
__global__ void __launch_bounds__(512, 2) MK_NO_PK fwd_kernel(Args args) {
    extern __shared__ __attribute__((aligned(256))) unsigned char lds_raw[];
    LAS unsigned char* lds = (LAS unsigned char*)lds_raw;
    Ctx c;
#pragma unroll
    for (int i = 0; i < 29; ++i) c.in[i] = args.in[i];
    c.out = args.out; c.ws = args.ws;
    if (threadIdx.x == 0) *(LAS u32x4*)(lds + LDS_BAR) = (u32x4){0u, 0u, 0u, 0u};
    __syncthreads();
    const XcdBarrier bar = xcd_barrier_post((unsigned*)(args.ws + WS_CTL), (volatile LAS unsigned*)(lds + LDS_BAR));
    const int lo = args.ph_lo, hi = args.ph_hi;
    LAS unsigned char* greg = lds + LDS_REG;
#ifndef MK_PHASE_MASK
#define MK_PHASE_MASK 0xFFFFFFu
#endif
#ifndef MK_NCONV
#define MK_NCONV 8u
#endif
#define PHASE(k) if (((MK_PHASE_MASK >> (k)) & 1u) && lo <= (k) && (k) < hi) { if ((k) > lo) xcd_barrier(bar);
#define ENDPHASE }
#ifndef MK_DUP
#define MK_DUP -1
#endif
    PHASE(0) p0_prologue(c, lds); if (MK_DUP == 0) p0_prologue(c, lds); ENDPHASE
    PHASE(1) s5_pass<1>(c, lds); if (MK_DUP == 1) s5_pass<1>(c, lds); ENDPHASE
    PHASE(2) s5_pass<2>(c, lds); if (MK_DUP == 1) s5_pass<2>(c, lds); ENDPHASE
    PHASE(3) { pg8::DenseSched S; S.so.init(32, 16, gridDim.x, blockIdx.x); S.A = (const char*)c.p<bf16_t>(WS_G); S.B = (const char*)c.p<bf16_t>(WS_WGLU); S.lda = 2048; S.ldb = 2048;
               pg8::EpiGLU E{c.in[I_X], c.p<float>(WS_H1), c.p<bf16_t>(WS_H1B), c.p<u64>(WS_SS1), 1.0f / (SC_G * SC_W)}; pg8::gemm_phase<pg8::EpiGLU, pg8::DenseSched, true>(greg, S, E, 16, 2048u); } ENDPHASE
    PHASE(4) { pg8::DenseSched S; S.so.init(32, 44, gridDim.x, blockIdx.x); S.A = (const char*)c.p<bf16_t>(WS_H1B); S.B = (const char*)c.p<bf16_t>(WS_WGU); S.lda = 4096; S.ldb = 4096;
               pg8::EpiSwiGLU<false> E{c.p<bf16_t>(WS_ACT1), c.p<u64>(WS_SS1), nullptr, 1.0f, {}, {}}; pg8::gemm_phase(greg, S, E, 32, 4096u);
               if (gridDim.x == 256u && blockIdx.x >= 128u) { __syncthreads(); late_convert(c, lds, (int)((blockIdx.x - 128u) * 8u + (threadIdx.x >> 6)), 1024); } } ENDPHASE
    PHASE(5) { pg8::DenseSched S; S.so.init(32, 8, gridDim.x, blockIdx.x); S.A = (const char*)c.p<bf16_t>(WS_ACT1); S.B = (const char*)c.p<bf16_t>(WS_WDN); S.lda = DFF * 2; S.ldb = DFF * 2;
               pg8::EpiResid E{c.p<bf16_t>(WS_H1B), nullptr, c.p<bf16_t>(WS_H2B), c.p<u64>(WS_SS2), c.ws + WS_H2F8, 1.0f}; pg8::gemm_phase(greg, S, E, 88, (unsigned)(DFF * 2)); } ENDPHASE
    PHASE(6) { pg8::DenseSched S; S.so.init(32, 21, gridDim.x, blockIdx.x); S.A = (const char*)(c.ws + WS_H2F8); S.B = (const char*)c.p<bf16_t>(WS_WIN); S.lda = 2048; S.ldb = 2048;
               pg8::EpiProj E{c.p<bf16_t>(WS_PROJ), c.p<u64>(WS_SS2), NSA_NP, 1.0f / (SC_H * SC_W), c.ws}; pg8::gemm_phase<pg8::EpiProj, pg8::DenseSched, true>(greg, S, E, 16, 2048u); } ENDPHASE
    PHASE(8) { CmpSched S{(int)gridDim.x, (int)blockIdx.x, c.ws}; pg8::EpiPart E{c.p<float>(WS_PART)}; pg8::gemm_phase(greg, S, E, 8, 8192u);
               { const int w8 = (int)(threadIdx.x >> 6);
                 if (gridDim.x == 256u) { if (blockIdx.x < 128u) p7_postproj(c, (int)blockIdx.x * 8 + w8, 1024, 1024); else p7_postproj(c, 1024 + (int)(blockIdx.x - 128u) * 8 + w8, 1024, L); }
                 else p7_postproj(c, (int)blockIdx.x * 8 + w8, (int)gridDim.x * 8, L); } } ENDPHASE
    PHASE(9) p9_cmpfinish(c, lds); if (MK_DUP == 7) p9_cmpfinish(c, lds); ENDPHASE
    PHASE(10) {
                const bool grp = (gridDim.x & 31u) == 0u;
                if (grp) { if (((blockIdx.x >> 3) & 3u) == 3u) { moe_convert(c, lds, (int)(((blockIdx.x >> 5) * 8u + (blockIdx.x & 7u)) * 8u + (threadIdx.x >> 6)), (int)((gridDim.x >> 5) * 64u)); __syncthreads(); } }
                else { moe_convert(c, lds, (int)(blockIdx.x * 8u + (threadIdx.x >> 6)), (int)(gridDim.x * 8u)); __syncthreads(); }
                p10_attention(c, lds);
                moe_convert_queue(c); } ENDPHASE
    PHASE(11) { pg8::DenseSched S; S.so.init(32, 8, gridDim.x, blockIdx.x); S.A = (const char*)(c.ws + WS_O); S.B = (const char*)c.p<bf16_t>(WS_WOUT); S.lda = 2048; S.ldb = 2048;
                pg8::EpiResid E{c.p<bf16_t>(WS_H2B), nullptr, c.p<bf16_t>(WS_H3B), c.p<u64>(WS_SS3), c.ws + WS_H3F8, 1.0f / (SC_O * SC_W)}; pg8::gemm_phase<pg8::EpiResid, pg8::DenseSched, true>(greg, S, E, 16, 2048u); } ENDPHASE
    PHASE(12) p12_router(c, lds); ENDPHASE
    PHASE(14) { moe_tables(c, lds);
                MoeSched<true> S{(const LAS int*)(lds + LDS_TAB), 44, (int)gridDim.x, (int)(((gridDim.x & 7u) == 0u) ? ((blockIdx.x & 7u) * (gridDim.x >> 3) + (blockIdx.x >> 3)) : blockIdx.x), (const char*)(c.ws + WS_H3F8), (const char*)(c.ws + WS_MGU), 2048u, 2048u, (size_t)11264 * 2048, c.p<int>(WS_ROWTOK)};
                pg8::EpiSwiGLU<true> E{c.p<bf16_t>(WS_ACT2), c.p<u64>(WS_SS3), c.p<float>(WS_ROWRS), 1.0f / (SC_H * SC_W), {}, {}}; pg8::gemm_phase<pg8::EpiSwiGLU<true>, MoeSched<true>, true>(greg, S, E, 16, 2048u); if (MK_DUP == 14) { __syncthreads(); pg8::gemm_phase<pg8::EpiSwiGLU<true>, MoeSched<true>, true>(greg, S, E, 16, 2048u); } } ENDPHASE
    PHASE(15) { if (lo == 15) moe_tables(c, lds);
                MoeSched<false> S{(const LAS int*)(lds + LDS_TAB), 8, (int)gridDim.x, (int)(((gridDim.x & 7u) == 0u) ? ((blockIdx.x & 7u) * (gridDim.x >> 3) + (blockIdx.x >> 3)) : blockIdx.x), (const char*)(c.ws + WS_ACT2), (const char*)(c.ws + WS_MDN), (unsigned)DFF, (unsigned)DFF, (size_t)2048 * DFF, nullptr};
                pg8::EpiMoeDown E{c.p<bf16_t>(WS_YR), c.p<float>(WS_ROWW), c.p<float>(WS_PART), {}}; pg8::gemm_phase<pg8::EpiMoeDown, MoeSched<false>, true>(greg, S, E, 44, (unsigned)DFF); } ENDPHASE
    PHASE(16) if (lo == 16) moe_tables(c, lds); p16_combine(c, lds); ENDPHASE
#if MK_LAST_PHASE < 17
    PHASE(17) if (MK_LAST_PHASE <= 7) dump_out(c); else copy_out(c, c.p<float>(MK_LAST_PHASE <= 4 ? WS_H1 : MK_LAST_PHASE <= 6 ? WS_H2 : WS_H3)); ENDPHASE
#endif
}

extern "C" void kernel_launch(void* const* d_in, const int* in_sizes, int n_in, void* d_out, int out_size, void* d_ws, size_t ws_size, hipStream_t stream) {
    static int grid = 0;
    if (grid == 0) {
        if (n_in != 29 || out_size != L * D || ws_size < WS_END) { fprintf(stderr, "kernel_launch: unexpected problem (n_in %d out %d ws %zu need %zu)\n", n_in, out_size, ws_size, (size_t)WS_END); grid = -1; return; }
        int dev = 0, cus = 0, per_cu = 0;
        if (hipGetDevice(&dev) != hipSuccess || hipDeviceGetAttribute(&cus, hipDeviceAttributeMultiprocessorCount, dev) != hipSuccess) { grid = -1; return; }
        if (hipFuncSetAttribute((const void*)fwd_kernel, hipFuncAttributeMaxDynamicSharedMemorySize, LDS_BYTES) != hipSuccess) { fprintf(stderr, "kernel_launch: hipFuncSetAttribute failed\n"); grid = -1; return; }
        if (hipOccupancyMaxActiveBlocksPerMultiprocessor(&per_cu, (const void*)fwd_kernel, 512, LDS_BYTES) != hipSuccess || per_cu < 1) { fprintf(stderr, "kernel_launch: occupancy query reports %d\n", per_cu); }
        (void)hipGetLastError();
        grid = cus;
    }
    if (grid < 0) return;
    (void)hipMemsetAsync((char*)d_ws + WS_CTL, 0, CTL_BYTES, stream);
    Args a{};
    for (int i = 0; i < 29; ++i) a.in[i] = (const float*)d_in[i];
    a.out = (float*)d_out; a.ws = (unsigned char*)d_ws;
    const int nph = (MK_LAST_PHASE < 17) ? 18 : 17;
#if MK_N_LAUNCHES == 1
    a.ph_lo = 0; a.ph_hi = nph;
    if (MK_LAST_PHASE < 17) {
        a.ph_lo = 0; a.ph_hi = MK_LAST_PHASE; hipLaunchKernelGGL(fwd_kernel, dim3(grid), dim3(512), LDS_BYTES, stream, a);
        a.ph_lo = 17; a.ph_hi = 18; hipLaunchKernelGGL(fwd_kernel, dim3(grid), dim3(512), LDS_BYTES, stream, a);
    } else hipLaunchKernelGGL(fwd_kernel, dim3(grid), dim3(512), LDS_BYTES, stream, a);
#else
    for (int ph = 0; ph < nph; ++ph) {
        if (ph >= MK_LAST_PHASE && ph < 17) continue;
        a.ph_lo = ph; a.ph_hi = ph + 1; hipLaunchKernelGGL(fwd_kernel, dim3(grid), dim3(512), LDS_BYTES, stream, a);
    }
#endif
    const hipError_t le = hipPeekAtLastError();
    if (le != hipSuccess) fprintf(stderr, "kernel_launch: launch failed: %s\n", hipGetErrorName(le));
}
```

```cpp
#include <hip/hip_runtime.h>
#include <cstdio>
#include <cstdint>

#ifndef MK_N_LAUNCHES
#define MK_N_LAUNCHES 1
#endif
#ifndef MK_LAST_PHASE
#define MK_LAST_PHASE 17
#endif

#define LAS __attribute__((address_space(3)))
typedef unsigned short bf16_t;
typedef short bf16x8 __attribute__((ext_vector_type(8)));
typedef short s16x4 __attribute__((ext_vector_type(4)));
typedef float f32x2 __attribute__((ext_vector_type(2)));
typedef float f32x4 __attribute__((ext_vector_type(4)));
typedef float f32x16 __attribute__((ext_vector_type(16)));
typedef unsigned u32x2 __attribute__((ext_vector_type(2)));
typedef unsigned u32x4 __attribute__((ext_vector_type(4)));
typedef __bf16 bf16x2_t __attribute__((ext_vector_type(2)));

constexpr int L = 8192, D = 2048, DFF = 5632, NE = 8;
constexpr int NSA_N = 5168, NSA_NP = 5376;
constexpr int MAXROWS = NE * L;
constexpr int NCMP = 512;
constexpr float RMS_EPS = 1e-6f;
constexpr float LOG2E = 1.4426950408889634f;
constexpr float QSCALE = 0.08838834764831845f * LOG2E;

constexpr size_t al256(size_t x) { return (x + 255) & ~(size_t)255; }
constexpr size_t WS_CTL   = 0;
constexpr size_t CTL_BYTES = 65536;
constexpr size_t WS_CNT   = WS_CTL + 32768;
constexpr size_t WS_SS1   = CTL_BYTES;
constexpr size_t WS_SS2   = WS_SS1 + al256((L + 1) * 8);
constexpr size_t WS_SS3   = WS_SS2 + al256((L + 1) * 8);
constexpr size_t WS_RSTDX = WS_SS3 + al256((L + 1) * 8);
constexpr size_t WS_LAMB  = WS_RSTDX + al256(L * 4);
constexpr size_t WS_BCT   = WS_LAMB + 128 * 64 * 8;
constexpr size_t WS_CT    = WS_BCT + 128 * 128 * 16 * 2;
constexpr size_t WS_SEND  = WS_CT + 128 * 16 * 128 * 2;
constexpr size_t WS_BIAS1 = WS_SEND + 32 * 128 * 64 * 8;
constexpr size_t WS_GATES = WS_BIAS1 + 2 * 256 * 4;
constexpr size_t WS_TOKE  = WS_GATES + (size_t)L * 48 * 4;
constexpr size_t WS_TOKP  = WS_TOKE + L * 8;
constexpr size_t WS_TOKW  = WS_TOKP + L * 8;
constexpr size_t WS_TOKD  = WS_TOKW + L * 8;
constexpr size_t WS_ROWTOK= WS_TOKD + L * 8;
constexpr size_t WS_ROWW  = WS_ROWTOK + al256(MAXROWS * 4);
constexpr size_t WS_ROWRS = al256(WS_ROWW + MAXROWS * 4);
constexpr size_t WS_WGLU  = al256(WS_ROWRS + MAXROWS * 4);
constexpr size_t WS_WGU   = WS_WGLU + (size_t)4096 * 2048 * 2;
constexpr size_t WS_WDN   = WS_WGU + (size_t)11264 * 2048 * 2;
constexpr size_t WS_WIN   = WS_WDN + (size_t)2048 * 5632 * 2;
constexpr size_t WS_WOUT  = WS_WIN + (size_t)NSA_NP * 2048 * 2;
constexpr size_t WS_CK1   = WS_WOUT + (size_t)2048 * 2048 * 2;
constexpr size_t WS_CV1   = WS_CK1 + (size_t)256 * 4096 * 2;
constexpr size_t WS_MGU   = WS_CV1 + (size_t)256 * 4096 * 2;
constexpr size_t WS_MDN   = WS_MGU + (size_t)8 * 11264 * 2048;
constexpr size_t WS_G     = WS_MDN + (size_t)8 * 2048 * 5632;
constexpr size_t WS_H1    = WS_G + (size_t)L * D * 2;
constexpr size_t WS_H1B   = WS_H1 + (size_t)L * D * 4;
constexpr size_t WS_ACT1  = WS_H1B + (size_t)L * D * 2;
constexpr size_t WS_H2    = WS_ACT1 + (size_t)L * DFF * 2;
constexpr size_t WS_H2B   = WS_H2 + (size_t)L * D * 4;
constexpr size_t WS_PROJ  = WS_H2B + (size_t)L * D * 2;
constexpr size_t WS_QN    = WS_PROJ + (size_t)L * NSA_NP * 2;
constexpr size_t KVH      = (size_t)(L + 16) * 128 * 2;
constexpr size_t WS_KC    = WS_QN + (size_t)L * D * 2;
constexpr size_t WS_VC    = WS_KC + 4 * KVH;
constexpr size_t WS_KSL   = WS_VC + 4 * KVH;
constexpr size_t WS_VSL   = WS_KSL + 4 * KVH;
constexpr size_t WS_KW    = WS_VSL + 4 * KVH;
constexpr size_t WS_VW    = WS_KW + 4 * KVH;
constexpr size_t WS_PART  = WS_VW + 4 * KVH;
constexpr size_t WS_KCMP  = WS_PART + (size_t)2 * 16 * 2048 * 256 * 4;
constexpr size_t WS_VCMP  = WS_KCMP + (size_t)4 * NCMP * 128 * 2;
constexpr size_t WS_O     = WS_VCMP + (size_t)4 * NCMP * 128 * 2;
constexpr size_t WS_H3    = WS_O + (size_t)L * D * 2;
constexpr size_t WS_H3B   = WS_H3 + (size_t)L * D * 4;
constexpr size_t WS_H3F8  = al256(WS_H3B + (size_t)(L + 1) * D * 2);
constexpr size_t WS_H2F8  = al256(WS_H3F8 + (size_t)(L + 1) * D);
constexpr size_t WS_ACT2  = al256(WS_H2F8 + (size_t)L * D);
constexpr size_t WS_YR    = WS_ACT2 + (size_t)MAXROWS * DFF;
constexpr size_t WS_END   = WS_YR + (size_t)MAXROWS * D * 2;

constexpr int LDS_BAR = 0;
constexpr int LDS_TAB = 64;
constexpr int LDS_REG = 256;
constexpr int LDS_BYTES = 152064;

__device__ __forceinline__ unsigned f2bf(float f) { unsigned u = __builtin_bit_cast(unsigned, f); return (u + 0x7fffu + ((u >> 16) & 1u)) >> 16; }
__device__ __forceinline__ unsigned pk2(float lo, float hi) { f32x2 v = {lo, hi}; bf16x2_t b = __builtin_convertvector(v, bf16x2_t); return __builtin_bit_cast(unsigned, b); }
__device__ __forceinline__ float bf2f(unsigned short b) { return __builtin_bit_cast(float, (unsigned)b << 16); }
__device__ __forceinline__ float fexp2(float x) { return __builtin_amdgcn_exp2f(x); }
__device__ __forceinline__ float frcp(float x) { return __builtin_amdgcn_rcpf(x); }
__device__ __forceinline__ float sigmoidf_(float x) { return frcp(1.0f + fexp2(-x * LOG2E)); }
__device__ __forceinline__ float gelu_tanh(float y) { const float z = 0.7978845608028654f * (y + 0.044715f * y * y * y); return y * frcp(1.0f + fexp2(-2.0f * LOG2E * z)); }
__device__ __forceinline__ void sincos_rev(float ang, float& s, float& c) { float rev = ang * 0.15915494309189535f; rev = rev - floorf(rev); s = __builtin_amdgcn_sinf(rev); c = __builtin_amdgcn_cosf(rev); }
__device__ __forceinline__ float wave_sum(float v) {
#pragma unroll
    for (int o = 1; o < 64; o <<= 1) v += __shfl_xor(v, o);
    return v;
}
typedef unsigned long long u64;
typedef int i32x4 __attribute__((ext_vector_type(4)));
typedef int i32x8 __attribute__((ext_vector_type(8)));
constexpr float SC_W = 512.0f, SC_H = 8.0f, SC_A = 4.0f, SC_O = 16.0f, SC_G = 16.0f;
__device__ __forceinline__ u32x2 pack8_fp8(const f32x4 a, const f32x4 b, const float sc) {
    int w0 = 0, w1 = 0;
    w0 = __builtin_amdgcn_cvt_pk_fp8_f32(a[0] * sc, a[1] * sc, w0, false); w0 = __builtin_amdgcn_cvt_pk_fp8_f32(a[2] * sc, a[3] * sc, w0, true);
    w1 = __builtin_amdgcn_cvt_pk_fp8_f32(b[0] * sc, b[1] * sc, w1, false); w1 = __builtin_amdgcn_cvt_pk_fp8_f32(b[2] * sc, b[3] * sc, w1, true);
    return (u32x2){(unsigned)w0, (unsigned)w1};
}
__device__ __forceinline__ void ss_add(u64* p, float ss) { atomicAdd(p, (u64)(ss * 65536.0f + 0.5f)); }
__device__ __forceinline__ float ss_rstd(const u64* p) { return rsqrtf((float)(*p) * (1.0f / 65536.0f / 2048.0f) + 1e-6f); }
__device__ __forceinline__ void cmadd(float lr, float li, float& hr, float& hi, float xr, float xi) {
    float t0, t1, nr, ni;
    asm("v_fma_f32 %0, -%1, %2, %3" : "=v"(t0) : "v"(li), "v"(hi), "v"(xr));
    asm("v_fma_f32 %0, %1, %2, %3" : "=v"(t1) : "v"(li), "v"(hr), "v"(xi));
    asm("v_fma_f32 %0, %1, %2, %3" : "=v"(nr) : "v"(lr), "v"(hr), "v"(t0));
    asm("v_fma_f32 %0, %1, %2, %3" : "=v"(ni) : "v"(lr), "v"(hi), "v"(t1));
    hr = nr; hi = ni;
}
__device__ __forceinline__ int crow(int i, int hh) { return (i & 3) + 8 * (i >> 2) + 4 * hh; }

#define XB_TMO      128
#define XB_XCNT(j)  (256  + 64 * (j))
#define XB_XSUB(j)  (1280 + 64 * (j))
#define XB_XGEN(j)  (2304 + 64 * (j))
#define XB_TOP      3328
#define XB_TOPGEN   3392
#define XCD_BAR_WORDS 3456
#define XB_SPIN_CAP (1u << 18)
__device__ __forceinline__ unsigned xb_ld(unsigned* p)              { return __hip_atomic_load(p, __ATOMIC_RELAXED, __HIP_MEMORY_SCOPE_AGENT); }
__device__ __forceinline__ unsigned xb_add(unsigned* p, unsigned v) { return __hip_atomic_fetch_add(p, v, __ATOMIC_RELAXED, __HIP_MEMORY_SCOPE_AGENT); }
__device__ __forceinline__ unsigned xb_xcc_id() { return (unsigned)__builtin_amdgcn_s_getreg((3 << 11) | 20) & 0xFu; }
#define XB_SPIN(cond, bar) do { unsigned _sp = 0; while (cond) { __builtin_amdgcn_s_sleep(1); \
    if ((++_sp & 255u) == 0u) { if (xb_ld(&(bar)[XB_TMO])) break; if (_sp > XB_SPIN_CAP) { atomicAdd(&(bar)[XB_TMO], 1u); break; } } } } while (0)
struct XcdBarrier { unsigned* bar; unsigned x; volatile LAS unsigned* st; };
__device__ __forceinline__ XcdBarrier xcd_barrier_post(unsigned* bar, volatile LAS unsigned* st) {
    XcdBarrier b; b.bar = bar; b.x = xb_xcc_id(); b.st = st;
    if (threadIdx.x == 0) (void)xb_add(&bar[XB_XCNT(b.x)], 1u);
    return b;
}
__device__ __forceinline__ void xcd_barrier_complete(unsigned* bar, unsigned x, unsigned& nloc, unsigned& nx) {
    const unsigned G = gridDim.x * gridDim.y * gridDim.z;
    unsigned sum, cnt, mine, sp = 0u;
    for (;;) {
        sum = 0u; cnt = 0u; mine = 0u;
#pragma unroll
        for (unsigned j = 0; j < 16; ++j) { const unsigned c = xb_ld(&bar[XB_XCNT(j)]); sum += c; cnt += (c > 0u) ? 1u : 0u; mine = (j == x) ? c : mine; }
        if (sum == G) break;
        __builtin_amdgcn_s_sleep(1);
        if ((++sp & 255u) == 0u) { if (xb_ld(&bar[XB_TMO])) break; if (sp > XB_SPIN_CAP) { atomicAdd(&bar[XB_TMO], 1u); break; } }
    }
    nloc = mine > 0u ? mine : 1u; nx = cnt > 0u ? cnt : 1u;
}
__device__ __forceinline__ void xcd_barrier(const XcdBarrier& b) {
    asm volatile("s_waitcnt vmcnt(0)" ::: "memory");
    __syncthreads();
    if (threadIdx.x == 0) {
        unsigned* bar = b.bar;
        __builtin_amdgcn_s_waitcnt(0);
        unsigned nloc = b.st[0], nx = b.st[1];
        if (nloc == 0u) { xcd_barrier_complete(bar, b.x, nloc, nx); b.st[0] = nloc; b.st[1] = nx; }
        const unsigned old = xb_add(&bar[XB_XSUB(b.x)], 1u);
        const unsigned gen = old / nloc;
        if (old + 1u == (gen + 1u) * nloc) {
            __builtin_amdgcn_fence(__ATOMIC_RELEASE, "agent");
            asm volatile("s_waitcnt vmcnt(0)" ::: "memory");
            const unsigned og = xb_add(&bar[XB_TOP], 1u);
            const unsigned tg = og / nx;
            if (og + 1u == (tg + 1u) * nx) xb_add(&bar[XB_TOPGEN], 1u);
            else XB_SPIN(xb_ld(&bar[XB_TOPGEN]) == tg, bar);
            __builtin_amdgcn_fence(__ATOMIC_ACQUIRE, "agent");
            xb_add(&bar[XB_XGEN(b.x)], 1u);
            asm volatile("s_waitcnt vmcnt(0)" ::: "memory");
        } else {
            XB_SPIN(xb_ld(&bar[XB_XGEN(b.x)]) == gen, bar);
            __builtin_amdgcn_fence(__ATOMIC_ACQUIRE, "agent");
            asm volatile("s_waitcnt vmcnt(0)" ::: "memory");
        }
    }
    __syncthreads();
}

struct Args { const float* in[29]; float* out; unsigned char* ws; int ph_lo, ph_hi; };
struct Ctx {
    const float* in[29]; float* out; unsigned char* ws;
    template <class T> __device__ __forceinline__ T* p(size_t off) const { return (T*)(ws + off); }
};
enum { I_X = 0, I_POS, I_NMIX, I_NFFN, I_ARE, I_AIM, I_LSTEP, I_BRE, I_BIM, I_CRE, I_CIM, I_SD, I_WGLU, I_WIN, I_QG, I_KG, I_PEK, I_PEV, I_CK1, I_CK2, I_CV1, I_CV2,
       I_WOUT, I_FGU, I_FDN, I_WR, I_BR, I_MGU, I_MDN };

namespace pg8 {
constexpr int BM = 256, BK = 64, HALF = 128, HTB = HALF * BK * 2, STAGE_BYTES = 8 * HTB, NXCD = 8, WGM = 8;
__device__ __forceinline__ int lds_byte(int r, int c) { const int st = (r >> 4) * 2 + (c >> 5), rr = r & 15, cc = c & 31, ob = rr * 64 + cc * 2; return st * 1024 + (ob ^ (((ob >> 9) & 1) << 5)); }
__device__ __forceinline__ void stage_rc(int b, int& R, int& C) { const int st = b / 1024, sb = b % 1024, swz = sb ^ (((sb >> 9) & 1) << 5); R = (st >> 1) * 16 + swz / 64; C = (st & 1) * 32 + (swz % 64) / 2; }
__device__ __forceinline__ int perm32(int rho) { const int n = rho >> 4, i = rho & 15; return 8 * (i >> 2) + 4 * n + (i & 3); }
struct Unit { int pm, pn, ax; };

struct StaticOrder {
    int nM, nN, nwg, G, c, wgm;
    __device__ __forceinline__ void init(int nM_, int nN_, int G_, int c_, int wgm_ = WGM) { nM = nM_; nN = nN_; nwg = nM * nN; G = G_; c = c_; wgm = wgm_; }
    __device__ __forceinline__ bool next(int i, Unit& u) const {
        const long Lx = (long)i * G + c; if (Lx >= nwg) return false;
        int wgid = (int)Lx; { const int q = nwg / NXCD, r = nwg % NXCD, xcd = wgid % NXCD, off = wgid / NXCD; wgid = (xcd < r ? xcd * (q + 1) : r * (q + 1) + (xcd - r) * q) + off; }
        const int nig = wgm * nN, gid = wgid / nig, fm = gid * wgm, gsz = (nM - fm) < wgm ? (nM - fm) : wgm;
        u.pm = fm + ((wgid % nig) % gsz); u.pn = (wgid % nig) / gsz; u.ax = 0; return true;
    }
};
struct DenseSched {
    StaticOrder so; const char* A; const char* B; unsigned lda, ldb;
    __device__ __forceinline__ bool next(int i, Unit& u) const { const bool ok = so.next(i, u); u.ax = u.pn; return ok; }
    __device__ __forceinline__ int unit_nt(const Unit&, int nt) const { return nt; }
    __device__ __forceinline__ const char* a_base(const Unit& u) const { return A + (size_t)u.pm * BM * lda; }
    __device__ __forceinline__ const char* b_base(const Unit& u) const { return B + (size_t)u.pn * BM * ldb; }
    __device__ __forceinline__ void a_rows(const Unit&, const int (&R)[2], unsigned (&o)[2][2]) const {
#pragma unroll
        for (int h = 0; h < 2; ++h)
#pragma unroll
            for (int i = 0; i < 2; ++i) o[h][i] = (unsigned)(h * HALF + R[i]) * lda;
    }
};

template <class Epi, class Sched, bool FP8 = false>
__device__ __forceinline__ void gemm_phase(LAS unsigned char* lds, const Sched& S, const Epi& E, const int nt, const unsigned ldb) {
    const int tid = threadIdx.x, wid = __builtin_amdgcn_readfirstlane(tid >> 6), lane = tid & 63, wr = wid >> 2, wc = wid & 3, fr = lane & 15, fq = lane >> 4;
    int R[2], C[2]; unsigned voffB[2];
#pragma unroll
    for (int i = 0; i < 2; ++i) { stage_rc(tid * 16 + i * 8192, R[i], C[i]); const int Rb = (R[i] & ~31) + perm32(R[i] & 31); voffB[i] = (unsigned)Rb * ldb + (unsigned)C[i] * 2u; }
    const size_t kstep = (size_t)(BK * 2);
    const size_t hstepB = (size_t)HALF * ldb;
    const unsigned ldsw = (unsigned)wid * 1024u;
    const int aoff = lds_byte(wr * 64 + fr, fq * 8), boff = lds_byte(wc * 32 + fr, fq * 8);
#define PG8_SA(b, h) (((b) * 2 + (h)) * HTB)
#define PG8_SB(b, h) ((4 + (b) * 2 + (h)) * HTB)
#define PG8_STAGE(bufoff, gbase, v0, v1) do { \
        __builtin_amdgcn_global_load_lds((const unsigned*)((const char*)(gbase) + (v0)), (LAS unsigned*)(lds + (bufoff) + ldsw), 16, 0, 0); \
        __builtin_amdgcn_global_load_lds((const unsigned*)((const char*)(gbase) + (v1)), (LAS unsigned*)(lds + (bufoff) + ldsw + 8192), 16, 0, 0); } while (0)
#define PG8_LD8(p) __builtin_shufflevector(*(const LAS i32x4*)(p), *(const LAS i32x4*)((p) + 1024), 0, 1, 2, 3, 4, 5, 6, 7)
#define PG8_LDA(dst, b, h) do { if constexpr (FP8) { _Pragma("unroll") for (int m = 0; m < 4; ++m) dst##8[m] = PG8_LD8(lds + PG8_SA(b, h) + aoff + m * 2048); } \
        else { _Pragma("unroll") for (int m = 0; m < 4; ++m) _Pragma("unroll") for (int k = 0; k < 2; ++k) dst[m][k] = *(const LAS bf16x8*)(lds + PG8_SA(b, h) + aoff + m * 2048 + k * 1024); } } while (0)
#define PG8_LDB(dst, b, h) do { if constexpr (FP8) { _Pragma("unroll") for (int n = 0; n < 2; ++n) dst##8[n] = PG8_LD8(lds + PG8_SB(b, h) + boff + n * 2048); } \
        else { _Pragma("unroll") for (int n = 0; n < 2; ++n) _Pragma("unroll") for (int k = 0; k < 2; ++k) dst[n][k] = *(const LAS bf16x8*)(lds + PG8_SB(b, h) + boff + n * 2048 + k * 1024); } } while (0)
#define PG8_MMA(ai, bj, At, Bt) do { __builtin_amdgcn_s_setprio(1); _Pragma("unroll") for (int m = 0; m < 4; ++m) _Pragma("unroll") for (int n = 0; n < 2; ++n) { \
        if constexpr (FP8) asm volatile("v_mfma_f32_16x16x128_f8f6f4 %0, %1, %2, %0" : "+v"(acc[ai][bj][m][n]) : "v"(Bt##8[n]), "v"(At##8[m])); \
        else { _Pragma("unroll") for (int k = 0; k < 2; ++k) acc[ai][bj][m][n] = __builtin_amdgcn_mfma_f32_16x16x32_bf16(Bt[n][k], At[m][k], acc[ai][bj][m][n], 0, 0, 0); } } \
        __builtin_amdgcn_s_setprio(0); } while (0)
#define PG8_WAIT_V(n) asm volatile("s_waitcnt vmcnt(" #n ")" ::: "memory")
#define PG8_WAIT_L(n) asm volatile("s_waitcnt lgkmcnt(" #n ")" ::: "memory")
#define PG8_BAR __builtin_amdgcn_s_barrier()
#define PG8_SCHED __builtin_amdgcn_sched_barrier(0)
    Unit cur, nxt; int ui = 0;
    if (!S.next(0, cur)) return;
    Epi Ee = E;
    Ee.pre(cur, wr, fr);
    f32x4 acc[2][2][4][2];
#pragma unroll
    for (int a = 0; a < 2; ++a)
#pragma unroll
        for (int b = 0; b < 2; ++b)
#pragma unroll
            for (int m = 0; m < 4; ++m)
#pragma unroll
                for (int n = 0; n < 2; ++n) acc[a][b][m][n] = (f32x4){0.f, 0.f, 0.f, 0.f};
    bf16x8 At[4][2], B0[2][2], B1[2][2]; i32x8 At8[4], B08[2], B18[2];
    unsigned cv[2][2], nv[2][2];
    S.a_rows(cur, R, cv);
#pragma unroll
    for (int h = 0; h < 2; ++h)
#pragma unroll
        for (int i = 0; i < 2; ++i) cv[h][i] += (unsigned)C[i] * 2u;
    const char* cA = S.a_base(cur); const char* cB = S.b_base(cur);
    PG8_STAGE(PG8_SB(0, 0), cB, voffB[0], voffB[1]); PG8_STAGE(PG8_SB(0, 1), cB + hstepB, voffB[0], voffB[1]); PG8_STAGE(PG8_SA(0, 0), cA, cv[0][0], cv[0][1]); PG8_STAGE(PG8_SA(0, 1), cA, cv[1][0], cv[1][1]);
    if (wr == 1) PG8_BAR;
    PG8_WAIT_V(2); PG8_BAR;
    PG8_STAGE(PG8_SB(1, 0), cB + kstep, voffB[0], voffB[1]); PG8_STAGE(PG8_SA(1, 0), cA + kstep, cv[0][0], cv[0][1]); PG8_STAGE(PG8_SB(1, 1), cB + hstepB + kstep, voffB[0], voffB[1]);
    PG8_WAIT_V(6); PG8_BAR;
    for (;;) {
        const bool has_next = S.next(ui + 1, nxt);
        const char* nA = cA; const char* nB = cB;
#pragma unroll
        for (int h = 0; h < 2; ++h)
#pragma unroll
            for (int i = 0; i < 2; ++i) nv[h][i] = cv[h][i];
        if (has_next) { nA = S.a_base(nxt); nB = S.b_base(nxt); S.a_rows(nxt, R, nv);
#pragma unroll
            for (int h = 0; h < 2; ++h)
#pragma unroll
                for (int i = 0; i < 2; ++i) nv[h][i] += (unsigned)C[i] * 2u; }
        const int ntc = S.unit_nt(cur, nt);
#pragma unroll 1
        for (int t = 0; t < ntc; t += 2) {
            const bool last = (t == ntc - 2);
            const char* a1 = cA + (size_t)(t + 1) * kstep;
            const char* a2 = last ? nA : cA + (size_t)(t + 2) * kstep; const char* b2 = last ? nB : cB + (size_t)(t + 2) * kstep;
            const char* a3 = a2 + kstep; const char* b3 = b2 + kstep;
            const unsigned w00 = last ? nv[0][0] : cv[0][0], w01 = last ? nv[0][1] : cv[0][1], w10 = last ? nv[1][0] : cv[1][0], w11 = last ? nv[1][1] : cv[1][1];
            PG8_LDB(B0, 0, 0); PG8_LDB(B1, 0, 1); PG8_SCHED; PG8_LDA(At, 0, 0); PG8_STAGE(PG8_SA(1, 1), a1, cv[1][0], cv[1][1]);
            PG8_WAIT_V(8); PG8_WAIT_L(0); PG8_BAR; PG8_MMA(0, 0, At, B0); PG8_MMA(0, 1, At, B1); PG8_BAR; PG8_SCHED;
            PG8_LDA(At, 0, 1); PG8_STAGE(PG8_SB(0, 0), b2, voffB[0], voffB[1]); PG8_STAGE(PG8_SB(0, 1), b2 + hstepB, voffB[0], voffB[1]); PG8_STAGE(PG8_SA(0, 0), a2, w00, w01);
            PG8_WAIT_V(8); PG8_WAIT_L(0); PG8_BAR; PG8_MMA(1, 0, At, B0); PG8_MMA(1, 1, At, B1); PG8_BAR; PG8_SCHED;
            PG8_LDB(B0, 1, 0); PG8_LDB(B1, 1, 1); PG8_SCHED; PG8_LDA(At, 1, 0); PG8_STAGE(PG8_SA(0, 1), a2, w10, w11);
            PG8_WAIT_V(8); PG8_WAIT_L(0); PG8_BAR; PG8_MMA(0, 0, At, B0); PG8_MMA(0, 1, At, B1); PG8_BAR; PG8_SCHED;
            PG8_LDA(At, 1, 1); PG8_STAGE(PG8_SB(1, 0), b3, voffB[0], voffB[1]); PG8_STAGE(PG8_SB(1, 1), b3 + hstepB, voffB[0], voffB[1]); PG8_STAGE(PG8_SA(1, 0), a3, w00, w01);
            PG8_WAIT_V(8); PG8_WAIT_L(0); PG8_BAR; PG8_MMA(1, 0, At, B0); PG8_MMA(1, 1, At, B1); PG8_BAR; PG8_SCHED;
        }
        if (wr == 0) PG8_BAR;
        if constexpr (FP8) asm volatile("s_nop 15\n\ts_nop 15" ::: "memory");
        Ee(acc, cur, wr, wc, fr, fq);
        if (!has_next) break;
#pragma unroll
        for (int a = 0; a < 2; ++a)
#pragma unroll
            for (int b = 0; b < 2; ++b)
#pragma unroll
                for (int m = 0; m < 4; ++m)
#pragma unroll
                    for (int n = 0; n < 2; ++n) acc[a][b][m][n] = (f32x4){0.f, 0.f, 0.f, 0.f};
        cur = nxt; cA = nA; cB = nB; ++ui;
        Ee.pre(cur, wr, fr);
#pragma unroll
        for (int h = 0; h < 2; ++h)
#pragma unroll
            for (int i = 0; i < 2; ++i) cv[h][i] = nv[h][i];
        if (wr == 1) PG8_BAR;
    }
    PG8_WAIT_V(0);
    PG8_BAR;
#undef PG8_SA
#undef PG8_SB
#undef PG8_STAGE
#undef PG8_LDA
#undef PG8_LDB
#undef PG8_MMA
#undef PG8_WAIT_V
#undef PG8_WAIT_L
#undef PG8_BAR
#undef PG8_SCHED
}

typedef f32x4 Acc[2][2][4][2];
__device__ __forceinline__ u32x4 pack8(const f32x4 a, const f32x4 b) { u32x4 w; w.x = pk2(a[0], a[1]); w.y = pk2(a[2], a[3]); w.z = pk2(b[0], b[1]); w.w = pk2(b[2], b[3]); return w; }
__device__ __forceinline__ float sumsq8(const f32x4 a, const f32x4 b) { return (a[0] * a[0] + a[1] * a[1]) + (a[2] * a[2] + a[3] * a[3]) + (b[0] * b[0] + b[1] * b[1]) + (b[2] * b[2] + b[3] * b[3]); }

struct EpiGLU {
    __device__ __forceinline__ void pre(const Unit&, int, int) {}
    const float* X; float* H; bf16_t* Hb; u64* SS; float accs;
    __device__ __forceinline__ void operator()(const Acc& acc, const Unit& u, int wr, int wc, int fr, int fq) const {
        const int col = u.pn * 128 + wc * 32 + fq * 8;
#pragma unroll
        for (int ai = 0; ai < 2; ++ai)
#pragma unroll
            for (int m = 0; m < 4; ++m) {
                const int row = u.pm * BM + ai * HALF + wr * 64 + m * 16 + fr; const size_t o = (size_t)row * D + col;
                f32x4 x0 = *(const f32x4*)(X + o), x1 = *(const f32x4*)(X + o + 4), h0, h1;
#pragma unroll
                for (int e = 0; e < 4; ++e) { h0[e] = x0[e] + acc[ai][0][m][0][e] * accs * sigmoidf_(acc[ai][1][m][0][e] * accs); h1[e] = x1[e] + acc[ai][0][m][1][e] * accs * sigmoidf_(acc[ai][1][m][1][e] * accs); }
                *(u32x4*)(Hb + o) = pack8(h0, h1);
                float ss = sumsq8(h0, h1); ss += __shfl_xor(ss, 16); ss += __shfl_xor(ss, 32);
                if (fq == 0) ss_add(SS + row, ss);
            }
    }
};
template <bool GATHER> struct EpiSwiGLU {
    bf16_t* ACT; const u64* SS; const float* rowrs; float accs;
    u64 ssv[GATHER ? 1 : 8]; float rsv[GATHER ? 8 : 1];
    __device__ __forceinline__ void pre(const Unit& u, int wr, int fr) {
#pragma unroll
        for (int ai = 0; ai < 2; ++ai)
#pragma unroll
            for (int m = 0; m < 4; ++m) { const int row = u.pm * BM + ai * HALF + wr * 64 + m * 16 + fr; if constexpr (GATHER) rsv[ai * 4 + m] = rowrs[row]; else ssv[ai * 4 + m] = SS[row]; }
    }
    __device__ __forceinline__ void operator()(const Acc& acc, const Unit& u, int wr, int wc, int fr, int fq) const {
        const int col = (u.ax & 255) * 128 + wc * 32 + fq * 8;
#pragma unroll
        for (int ai = 0; ai < 2; ++ai)
#pragma unroll
            for (int m = 0; m < 4; ++m) {
                const int row = u.pm * BM + ai * HALF + wr * 64 + m * 16 + fr;
                float rs;
                if constexpr (GATHER) rs = rsv[ai * 4 + m] * accs; else rs = rsqrtf((float)ssv[ai * 4 + m] * (1.0f / 65536.0f / 2048.0f) + 1e-6f);
                f32x4 a0, a1;
#pragma unroll
                for (int e = 0; e < 4; ++e) { const float g0 = acc[ai][0][m][0][e] * rs, g1 = acc[ai][0][m][1][e] * rs;
                    a0[e] = g0 * sigmoidf_(g0) * (acc[ai][1][m][0][e] * rs); a1[e] = g1 * sigmoidf_(g1) * (acc[ai][1][m][1][e] * rs); }
                if constexpr (GATHER) *(u32x2*)((unsigned char*)ACT + (size_t)row * DFF + col) = pack8_fp8(a0, a1, SC_A);
                else *(u32x4*)(ACT + (size_t)row * DFF + col) = pack8(a0, a1);
            }
    }
};
struct EpiResid {
    __device__ __forceinline__ void pre(const Unit&, int, int) {}
    const bf16_t* Hin; float* Hout; bf16_t* Hb; u64* SS; unsigned char* H8; float accs;
    __device__ __forceinline__ void operator()(const Acc& acc, const Unit& u, int wr, int wc, int fr, int fq) const {
#pragma unroll
        for (int ai = 0; ai < 2; ++ai)
#pragma unroll
            for (int m = 0; m < 4; ++m) {
                const int row = u.pm * BM + ai * HALF + wr * 64 + m * 16 + fr; float ss = 0.f;
#pragma unroll
                for (int bj = 0; bj < 2; ++bj) { const size_t o = (size_t)row * D + u.pn * BM + bj * HALF + wc * 32 + fq * 8;
                    const u32x4 rb = *(const u32x4*)(Hin + o); f32x4 r0, r1;
#pragma unroll
                    for (int q = 0; q < 2; ++q) { r0[2 * q] = __builtin_bit_cast(float, rb[q] << 16); r0[2 * q + 1] = __builtin_bit_cast(float, rb[q] & 0xffff0000u); r1[2 * q] = __builtin_bit_cast(float, rb[2 + q] << 16); r1[2 * q + 1] = __builtin_bit_cast(float, rb[2 + q] & 0xffff0000u); }
                    const f32x4 h0 = r0 + acc[ai][bj][m][0] * accs, h1 = r1 + acc[ai][bj][m][1] * accs;
                    if (Hout) { *(f32x4*)(Hout + o) = h0; *(f32x4*)(Hout + o + 4) = h1; }
                    *(u32x4*)(Hb + o) = pack8(h0, h1); ss += sumsq8(h0, h1);
                    if (H8) *(u32x2*)(H8 + o) = pack8_fp8(h0, h1, SC_H); }
                ss += __shfl_xor(ss, 16); ss += __shfl_xor(ss, 32);
                if (fq == 0) ss_add(SS + row, ss);
            }
    }
};
struct EpiProj {
    bf16_t* P; const u64* SS; int ldc; float accs; unsigned char* ws;
    u64 ssv[8];
    __device__ __forceinline__ void pre(const Unit& u, int wr, int fr) {
#pragma unroll
        for (int ai = 0; ai < 2; ++ai)
#pragma unroll
            for (int m = 0; m < 4; ++m) ssv[ai * 4 + m] = SS[u.pm * BM + ai * HALF + wr * 64 + m * 16 + fr];
    }
    __device__ __forceinline__ void operator()(const Acc& acc, const Unit& u, int wr, int wc, int fr, int fq) const {
#pragma unroll
        for (int ai = 0; ai < 2; ++ai)
#pragma unroll
            for (int m = 0; m < 4; ++m) {
                const int row = u.pm * BM + ai * HALF + wr * 64 + m * 16 + fr; const float rs = rsqrtf((float)ssv[ai * 4 + m] * (1.0f / 65536.0f / 2048.0f) + 1e-6f) * accs;
#pragma unroll
                for (int bj = 0; bj < 2; ++bj) {
                    const int slot = 2 * u.pn + bj, kind = slot < 16 ? 0 : ((slot - 16) >> 2) + 1;
                    const u32x4 v = pack8(acc[ai][bj][m][0] * rs, acc[ai][bj][m][1] * rs);
                    if (kind == 1 || kind == 2 || kind == 4 || kind == 6) {
                        const size_t base = kind == 1 ? WS_KC : kind == 2 ? WS_VC : kind == 4 ? WS_VSL : WS_VW;
                        *(u32x4*)((bf16_t*)(ws + base + (size_t)((slot - 16) & 3) * KVH) + (size_t)row * 128 + wc * 32 + fq * 8) = v;
                    } else *(u32x4*)(P + (size_t)row * ldc + u.pn * BM + bj * HALF + wc * 32 + fq * 8) = v;
                }
            }
    }
};
struct EpiPart {
    __device__ __forceinline__ void pre(const Unit&, int, int) {}
    float* P;
    __device__ __forceinline__ void operator()(const Acc& acc, const Unit& u, int wr, int wc, int fr, int fq) const {
#pragma unroll
        for (int ai = 0; ai < 2; ++ai)
#pragma unroll
            for (int m = 0; m < 4; ++m) {
                const int row = u.pm * BM + ai * HALF + wr * 64 + m * 16 + fr;
#pragma unroll
                for (int bj = 0; bj < 2; ++bj) *(u32x4*)((bf16_t*)P + ((size_t)u.ax * 2048 + row) * 256 + bj * HALF + wc * 32 + fq * 8) = pack8(acc[ai][bj][m][0], acc[ai][bj][m][1]);
            }
    }
};
struct EpiMoeDown {
    bf16_t* Y; const float* roww; float* part;
    float wv[8];
    __device__ __forceinline__ void pre(const Unit& u, int wr, int fr) {
#pragma unroll
        for (int ai = 0; ai < 2; ++ai)
#pragma unroll
            for (int m = 0; m < 4; ++m) wv[ai * 4 + m] = roww[u.pm * BM + ai * HALF + wr * 64 + m * 16 + fr];
    }
    __device__ __forceinline__ void operator()(const Acc& acc, const Unit& u, int wr, int wc, int fr, int fq) const {
        const int sub = (u.ax >> 8) & 15, pn = u.ax & 255;
        int rbase = wr * 64 + fr; asm volatile("" : "+v"(rbase));
#pragma unroll
        for (int ai = 0; ai < 2; ++ai)
#pragma unroll
            for (int m = 0; m < 4; ++m) {
                const int rl = ai * HALF + m * 16 + rbase, row = u.pm * BM + rl;
                const float w = wv[ai * 4 + m] * (1.0f / (SC_A * SC_W));
                if (sub) {
                    bf16_t* pp = (bf16_t*)part + ((size_t)((sub - 1) * 64 + (u.ax >> 16)) * 256 + rl) * 256;
#pragma unroll
                    for (int bj = 0; bj < 2; ++bj) *(u32x4*)(pp + bj * HALF + wc * 32 + fq * 8) = pack8(acc[ai][bj][m][0] * w, acc[ai][bj][m][1] * w);
                } else {
#pragma unroll
                    for (int bj = 0; bj < 2; ++bj) *(u32x4*)(Y + (size_t)row * D + pn * BM + bj * HALF + wc * 32 + fq * 8) = pack8(acc[ai][bj][m][0] * w, acc[ai][bj][m][1] * w);
                }
            }
    }
};
}

__device__ __forceinline__ void conv_load(const float* __restrict__ W, int Nsrc, int Ndst, int off1, int item, int lane, f32x4 (&v)[8]) {
    const int nblk = Ndst >> 5, kb = item / nblk, nb = item - kb * nblk, k0 = kb * 64, r0 = nb * 32;
    int c0 = r0;
    if (off1) { const int p = r0 >> 8, b = (r0 >> 7) & 1, i = r0 & 127; c0 = b * off1 + 128 * p + i; }
    const int n4 = (lane & 7) * 4;
    const bool ok = (c0 + n4) < Nsrc;
#pragma unroll
    for (int i = 0; i < 8; ++i) { const int kk = 8 * i + (lane >> 3); v[i] = ok ? __builtin_nontemporal_load((const f32x4*)(W + (size_t)(k0 + kk) * Nsrc + c0 + n4)) : (f32x4){0.f, 0.f, 0.f, 0.f}; }
}
template <bool FP8>
__device__ __forceinline__ void conv_store(int K, int Ndst, const float* __restrict__ gain, bf16_t* __restrict__ WT, int item, LAS float* scr, int lane, const f32x4 (&v)[8]) {
    const int nblk = Ndst >> 5, kb = item / nblk, nb = item - kb * nblk, k0 = kb * 64, r0 = nb * 32;
    const int n4 = (lane & 7) * 4;
#pragma unroll
    for (int i = 0; i < 8; ++i) { const int kk = 8 * i + (lane >> 3);
#pragma unroll
        for (int e = 0; e < 4; ++e) scr[kk * 33 + n4 + e] = v[i][e]; }
    __builtin_amdgcn_fence(__ATOMIC_RELEASE, "wavefront"); __builtin_amdgcn_wave_barrier(); __builtin_amdgcn_fence(__ATOMIC_ACQUIRE, "wavefront");
    const int c = lane & 7;
    float gv[8];
#pragma unroll
    for (int j = 0; j < 8; ++j) gv[j] = gain ? gain[k0 + 8 * c + j] : 1.0f;
#pragma unroll
    for (int j = 0; j < 4; ++j) { const int n = (lane >> 3) + 8 * j; const LAS float* s = scr + (8 * c) * 33 + n;
        if constexpr (FP8) { const f32x4 a = {s[0] * gv[0], s[33] * gv[1], s[2 * 33] * gv[2], s[3 * 33] * gv[3]}, b = {s[4 * 33] * gv[4], s[5 * 33] * gv[5], s[6 * 33] * gv[6], s[7 * 33] * gv[7]};
            *(u32x2*)((unsigned char*)WT + (size_t)(r0 + n) * K + k0 + 8 * c) = pack8_fp8(a, b, SC_W); }
        else { u32x4 o; o.x = pk2(s[0] * gv[0], s[33] * gv[1]); o.y = pk2(s[2 * 33] * gv[2], s[3 * 33] * gv[3]); o.z = pk2(s[4 * 33] * gv[4], s[5 * 33] * gv[5]); o.w = pk2(s[6 * 33] * gv[6], s[7 * 33] * gv[7]);
            *(u32x4*)(WT + (size_t)(r0 + n) * K + k0 + 8 * c) = o; } }
    __builtin_amdgcn_fence(__ATOMIC_RELEASE, "wavefront"); __builtin_amdgcn_wave_barrier(); __builtin_amdgcn_fence(__ATOMIC_ACQUIRE, "wavefront");
}
template <bool FP8 = false>
__device__ __forceinline__ void conv_job(const float* W, int K, int Nsrc, int Ndst, int off1, const float* gain, bf16_t* WT, LAS float* scr, int gw, int nw, int lane) {
    const int items = (K >> 6) * (Ndst >> 5);
    if (gw >= items) return;
    f32x4 va[8], vb[8], vc[8];
    conv_load(W, Nsrc, Ndst, off1, gw, lane, va);
    if (gw + nw < items) conv_load(W, Nsrc, Ndst, off1, gw + nw, lane, vb);
    for (int it = gw; it < items; it += 3 * nw) {
        const int i1 = it + nw, i2 = it + 2 * nw, i3 = it + 3 * nw, i4 = it + 4 * nw;
        if (i2 < items) conv_load(W, Nsrc, Ndst, off1, i2, lane, vc);
        conv_store<FP8>(K, Ndst, gain, WT, it, scr, lane, va);
        if (i1 < items) { if (i3 < items) conv_load(W, Nsrc, Ndst, off1, i3, lane, va); conv_store<FP8>(K, Ndst, gain, WT, i1, scr, lane, vb); }
        if (i2 < items) { if (i4 < items) conv_load(W, Nsrc, Ndst, off1, i4, lane, vb); conv_store<FP8>(K, Ndst, gain, WT, i2, scr, lane, vc); }
    }
}

__device__ __forceinline__ void conv8_load(const float* __restrict__ W, int Nsrc, int Ndst, int off1, int item, int lane, f32x4 (&v)[16]) {
    const int nblk = Ndst >> 5, kb = item / nblk, nb = item - kb * nblk, k0 = kb * 128, r0 = nb * 32;
    int c0 = r0;
    if (off1) { const int p = r0 >> 8, b = (r0 >> 7) & 1, i = r0 & 127; c0 = b * off1 + 128 * p + i; }
    const int n4 = (lane & 7) * 4, g = lane >> 3;
#pragma unroll
    for (int i = 0; i < 16; ++i) v[i] = __builtin_nontemporal_load((const f32x4*)(W + (size_t)(k0 + 16 * g + i) * Nsrc + c0 + n4));
}
__device__ __forceinline__ void conv8_store(int K, int Ndst, const float* __restrict__ gain, unsigned char* __restrict__ WT, int item, int lane, const f32x4 (&v)[16]) {
    const int nblk = Ndst >> 5, kb = item / nblk, nb = item - kb * nblk, k0 = kb * 128, r0 = nb * 32;
    const int n4 = (lane & 7) * 4, g = lane >> 3;
    float gv[16];
#pragma unroll
    for (int j = 0; j < 16; ++j) gv[j] = gain ? gain[k0 + 16 * g + j] : 1.0f;
#pragma unroll
    for (int e = 0; e < 4; ++e) {
        const f32x4 a = {v[0][e] * gv[0], v[1][e] * gv[1], v[2][e] * gv[2], v[3][e] * gv[3]}, b = {v[4][e] * gv[4], v[5][e] * gv[5], v[6][e] * gv[6], v[7][e] * gv[7]};
        const f32x4 cc = {v[8][e] * gv[8], v[9][e] * gv[9], v[10][e] * gv[10], v[11][e] * gv[11]}, d = {v[12][e] * gv[12], v[13][e] * gv[13], v[14][e] * gv[14], v[15][e] * gv[15]};
        const u32x2 lo = pack8_fp8(a, b, SC_W), hi = pack8_fp8(cc, d, SC_W);
        *(u32x4*)(WT + (size_t)(r0 + n4 + e) * K + k0 + 16 * g) = (u32x4){lo.x, lo.y, hi.x, hi.y};
    }
}
__device__ __forceinline__ void conv8_job(const float* W, int K, int Nsrc, int Ndst, int off1, const float* gain, unsigned char* WT, int gw, int nw, int lane) {
    const int items = (K >> 7) * (Ndst >> 5);
    if (gw >= items) return;
    f32x4 va[16], vb[16];
    conv8_load(W, Nsrc, Ndst, off1, gw, lane, va);
    for (int it = gw; it < items; it += 2 * nw) {
        const int i1 = it + nw, i2 = it + 2 * nw;
        if (i1 < items) conv8_load(W, Nsrc, Ndst, off1, i1, lane, vb);
        conv8_store(K, Ndst, gain, WT, it, lane, va);
        if (i1 < items) { if (i2 < items) conv8_load(W, Nsrc, Ndst, off1, i2, lane, va); conv8_store(K, Ndst, gain, WT, i1, lane, vb); }
    }
}
__device__ __forceinline__ void late_convert(const Ctx& c, LAS unsigned char* lds, int gw, int nw) {
    const int lane = threadIdx.x & 63, wid = threadIdx.x >> 6;
    LAS float* scr = (LAS float*)(lds + LDS_REG) + wid * (64 * 33);
    conv_job(c.in[I_FDN], 5632, 2048, 2048, 0, nullptr, c.p<bf16_t>(WS_WDN), scr, gw, nw, lane);
    conv_job<true>(c.in[I_WIN], 2048, NSA_N, NSA_NP, 0, c.in[I_NMIX] + D, c.p<bf16_t>(WS_WIN), scr, gw, nw, lane);
    conv_job<true>(c.in[I_WOUT], 2048, 2048, 2048, 0, nullptr, c.p<bf16_t>(WS_WOUT), scr, gw, nw, lane);
    conv_job(c.in[I_CK1], 4096, 256, 256, 0, nullptr, c.p<bf16_t>(WS_CK1), scr, gw, nw, lane);
    conv_job(c.in[I_CV1], 4096, 256, 256, 0, nullptr, c.p<bf16_t>(WS_CV1), scr, gw, nw, lane);
}
__device__ __forceinline__ void p0_prologue(const Ctx& c, LAS unsigned char* lds) {
    const int tid = threadIdx.x, lane = tid & 63, wid = tid >> 6;
    const int gw = blockIdx.x * 8 + wid, nw = gridDim.x * 8;
    const int gt = blockIdx.x * 512 + tid, ntr = gridDim.x * 512;
    for (int i = gt; i < L + 1; i += ntr) { c.p<u64>(WS_SS1)[i] = 0ull; c.p<u64>(WS_SS2)[i] = 0ull; c.p<u64>(WS_SS3)[i] = 0ull; }
    for (int i = gt; i < D / 2; i += ntr) c.p<unsigned>(WS_H3B)[(size_t)L * D / 2 + i] = 0u;
    for (int i = gt; i < D / 4; i += ntr) c.p<unsigned>(WS_H3F8)[(size_t)L * D / 4 + i] = 0u;
    for (int i = gt; i < 8 * 16 * 64; i += ntr) { const int pl = i / (16 * 64), r = i % (16 * 64);
        unsigned* base = (unsigned*)(c.ws + (pl < 4 ? WS_KC + pl * KVH : WS_VC + (pl - 4) * KVH) + (size_t)L * 256); base[r] = 0u; }
    for (int i = gt; i < MAXROWS; i += ntr) { c.p<int>(WS_ROWTOK)[i] = L; c.p<float>(WS_ROWW)[i] = 0.f; c.p<float>(WS_ROWRS)[i] = 0.f; }
    for (int t = gw; t < L; t += 4 * nw) {
        f32x4 v[4][8];
#pragma unroll
        for (int q = 0; q < 4; ++q) { const int tq = t + q * nw; const f32x4* xr = (const f32x4*)(c.in[I_X] + (size_t)(tq < L ? tq : t) * D);
#pragma unroll
            for (int j = 0; j < 8; ++j) v[q][j] = xr[lane + 64 * j]; }
#pragma unroll
        for (int q = 0; q < 4; ++q) { const int tq = t + q * nw; float s = 0.f;
#pragma unroll
            for (int j = 0; j < 8; ++j) s += (v[q][j][0] * v[q][j][0] + v[q][j][1] * v[q][j][1]) + (v[q][j][2] * v[q][j][2] + v[q][j][3] * v[q][j][3]);
            s = wave_sum(s);
            if (lane == 0 && tq < L) c.p<float>(WS_RSTDX)[tq] = rsqrtf(s * (1.0f / D) + RMS_EPS); }
    }
    for (int i = (int)blockIdx.x * 32 + tid; tid < 32 && i < 128 * 64; i += (int)gridDim.x * 32) {
        const int g = i >> 6, p = i & 63;
        const float dt = __expf(c.in[I_LSTEP][g]), ar = c.in[I_ARE][i], ai = c.in[I_AIM][i];
        const float mag = __expf(ar * dt); float sn, cs; sincos_rev(ai * dt, sn, cs);
        const float lbr = mag * cs, lbi = mag * sn, den = ar * ar + ai * ai, nr = lbr - 1.0f;
        const float cre = (nr * ar + lbi * ai) / den, cim = (lbi * ar - nr * ai) / den;
        c.p<f32x2>(WS_LAMB)[i] = (f32x2){lbr, lbi};
        const float* bre = c.in[I_BRE] + (size_t)i * 16; const float* bim = c.in[I_BIM] + (size_t)i * 16;
        bf16_t* bo_re = c.p<bf16_t>(WS_BCT) + ((size_t)g * 128 + p) * 16; bf16_t* bo_im = bo_re + 64 * 16;
#pragma unroll
        for (int k = 0; k < 16; ++k) { bo_re[k] = (bf16_t)f2bf(cre * bre[k] - cim * bim[k]); bo_im[k] = (bf16_t)f2bf(cre * bim[k] + cim * bre[k]); }
        bf16_t* ct = c.p<bf16_t>(WS_CT) + (size_t)g * 16 * 128;
#pragma unroll
        for (int k = 0; k < 16; ++k) { ct[k * 128 + 2 * p] = (bf16_t)f2bf(c.in[I_CRE][((size_t)g * 16 + k) * 64 + p]); ct[k * 128 + 2 * p + 1] = (bf16_t)f2bf(-c.in[I_CIM][((size_t)g * 16 + k) * 64 + p]); }
    }
    for (int job = ((wid + 4) & 7) * (int)gridDim.x + (int)blockIdx.x; job < 256; job += nw) {
        const int kv = job >> 7, k0 = (job & 127) * 32; const float* pe = c.in[kv ? I_PEV : I_PEK] + k0; const float* w1 = c.in[kv ? I_CV1 : I_CK1] + (size_t)k0 * 256 + 4 * lane;
        f32x4 a4 = {0.f, 0.f, 0.f, 0.f};
        f32x4 wrow[32];
#pragma unroll
        for (int r = 0; r < 32; ++r) wrow[r] = *(const f32x4*)(w1 + (size_t)r * 256);
#pragma unroll
        for (int r = 0; r < 32; ++r) a4 = a4 + wrow[r] * pe[r];
        u64* bacc = (u64*)(c.ws + WS_CTL + 16384) + kv * 256 + 4 * lane;
#pragma unroll
        for (int e = 0; e < 4; ++e) atomicAdd(bacc + e, (u64)(long long)((double)a4[e] * 1099511627776.0));
    }
    LAS float* scr = (LAS float*)(lds + LDS_REG) + wid * (64 * 33);
    conv_job<true>(c.in[I_WGLU], 2048, 4096, 4096, 2048, nullptr, c.p<bf16_t>(WS_WGLU), scr, gw, nw, lane);
    conv_job(c.in[I_FGU], 2048, 11264, 11264, 5632, c.in[I_NFFN], c.p<bf16_t>(WS_WGU), scr, gw, nw, lane);
    if (gridDim.x != 256u) late_convert(c, lds, gw, nw);
}


#ifndef MK_DYN_DN
#define MK_DYN_DN 3
#endif
__device__ __forceinline__ void moe_convert(const Ctx& c, LAS unsigned char* lds, int gw, int nw) {
    const int lane = threadIdx.x & 63;
    for (int e = 0; e < NE; ++e) conv8_job(c.in[I_MGU] + (size_t)e * 2048 * 11264, 2048, 11264, 11264, 5632, c.in[I_NFFN] + D, c.ws + WS_MGU + (size_t)e * 11264 * 2048, gw, nw, lane);
    for (int e = 0; e < NE - MK_DYN_DN; ++e) conv8_job(c.in[I_MDN] + (size_t)e * 5632 * 2048, 5632, 2048, 2048, 0, nullptr, c.ws + WS_MDN + (size_t)e * 2048 * 5632, gw, nw, lane);
}

constexpr int CV_GU_ITEMS = (2048 / 128) * (11264 / 32), CV_DN_ITEMS = (5632 / 128) * (2048 / 32), CV_TOTAL = NE * (CV_GU_ITEMS + CV_DN_ITEMS), CV_CH = 4;
static_assert(CV_TOTAL % CV_CH == 0, "conversion chunks");
__device__ __forceinline__ void moe_convert_queue(const Ctx& c) {
    const int lane = threadIdx.x & 63;
    unsigned* ctr = c.p<unsigned>(WS_CNT) + 1088;
    auto pop = [&]() -> int { unsigned v = 0; if (lane == 0) v = atomicAdd(ctr, (unsigned)CV_CH); return (int)v; };
    auto ld = [&](int it, f32x4 (&v)[16]) {
        if (it < NE * CV_GU_ITEMS) { const int e = it / CV_GU_ITEMS, i = it - e * CV_GU_ITEMS; conv8_load(c.in[I_MGU] + (size_t)e * 2048 * 11264, 11264, 11264, 5632, i, lane, v); }
        else { const int j = it - NE * CV_GU_ITEMS, e = j / CV_DN_ITEMS, i = j - e * CV_DN_ITEMS; conv8_load(c.in[I_MDN] + (size_t)e * 5632 * 2048, 2048, 2048, 0, i, lane, v); }
    };
    auto st = [&](int it, const f32x4 (&v)[16]) {
        if (it < NE * CV_GU_ITEMS) { const int e = it / CV_GU_ITEMS, i = it - e * CV_GU_ITEMS; conv8_store(2048, 11264, c.in[I_NFFN] + D, c.ws + WS_MGU + (size_t)e * 11264 * 2048, i, lane, v); }
        else { const int j = it - NE * CV_GU_ITEMS, e = j / CV_DN_ITEMS, i = j - e * CV_DN_ITEMS; conv8_store(5632, 2048, nullptr, c.ws + WS_MDN + (size_t)e * 2048 * 5632, i, lane, v); }
    };
    constexpr int CV_FIRST = NE * CV_GU_ITEMS + (NE - MK_DYN_DN) * CV_DN_ITEMS;
    int base = CV_FIRST + __builtin_amdgcn_readfirstlane(pop());
    if (base >= CV_TOTAL) return;
    int nraw = pop(), pos = 0;
    auto next_item = [&]() -> int { if (pos == CV_CH) { base = CV_FIRST + __builtin_amdgcn_readfirstlane(nraw); pos = 0; if (base < CV_TOTAL) nraw = pop(); } return base < CV_TOTAL ? base + pos++ : CV_TOTAL; };
    f32x4 va[16], vb[16];
    int a = next_item();
    ld(a, va);
    for (;;) {
        const int b = next_item();
        if (b < CV_TOTAL) ld(b, vb);
        st(a, va);
        if (b >= CV_TOTAL) break;
        a = next_item();
        if (a < CV_TOTAL) ld(a, va);
        st(b, vb);
        if (a >= CV_TOTAL) break;
    }
}

constexpr int XS_STRIDE = 132;
constexpr int XR = 68;
template <int PASS>
__device__ __forceinline__ void s5_pass(const Ctx& c, LAS unsigned char* lds) {
    const int tid = threadIdx.x, lane = tid & 63, wid = tid >> 6, hh = lane >> 5, r = lane & 31, l15 = lane & 15, fq = lane >> 4;
    LAS unsigned* Xw = (LAS unsigned*)(lds + LDS_REG) + wid * (32 * XR);
    LAS float* Us = (LAS float*)(lds + LDS_REG + 8 * 32 * XR * 4) + wid * 512;
    const float* X = c.in[I_X]; const float* gain = c.in[I_NMIX]; const float* rstd = c.p<float>(WS_RSTDX);
    for (int item = blockIdx.x * 8 + wid; item < 32 * 128; item += gridDim.x * 8) {
        const int chunk = item >> 7, g = item & 127, t0 = chunk * 256;
        const f32x2 lam = c.p<f32x2>(WS_LAMB)[g * 64 + lane];
        bf16x8 bfr[4];
#pragma unroll
        for (int nb = 0; nb < 4; ++nb) bfr[nb] = *(const bf16x8*)(c.p<bf16_t>(WS_BCT) + ((size_t)g * 128 + 32 * nb + r) * 16 + 8 * hh);
        float g8[8];
#pragma unroll
        for (int j = 0; j < 8; ++j) g8[j] = gain[16 * g + 8 * hh + j];
        bf16x8 cfr[4]; float dsk = 0.f;
        if (PASS == 2) {
#pragma unroll
            for (int ks = 0; ks < 4; ++ks) cfr[ks] = *(const bf16x8*)(c.p<bf16_t>(WS_CT) + ((size_t)g * 16 + l15) * 128 + 32 * ks + 8 * fq);
            dsk = c.in[I_SD][16 * g + l15];
        }
        float hr = 0.f, hi = 0.f;
        if (PASS == 2 && chunk > 0) {
            float pr = lam[0], pi = lam[1];
#pragma unroll
            for (int q = 0; q < 8; ++q) { const float a = pr * pr - pi * pi, b = 2.f * pr * pi; pr = a; pi = b; }
            const f32x2* se = c.p<f32x2>(WS_SEND) + g * 64 + lane;
            f32x2 sv[31];
#pragma unroll
            for (int j = 0; j < 31; ++j) sv[j] = (j < chunk) ? se[(size_t)j * 128 * 64] : (f32x2){0.f, 0.f};
#pragma unroll
            for (int j = 0; j < 31; ++j) if (j < chunk) cmadd(pr, pi, hr, hi, sv[j][0], sv[j][1]);
        }
        f32x4 ua[8], ub[8]; float rsa[8];
#pragma unroll
        for (int tile = 0; tile < 8; ++tile) { const size_t o = (size_t)(t0 + 32 * tile + r) * D + 16 * g + 8 * hh; ua[tile] = *(const f32x4*)(X + o); ub[tile] = *(const f32x4*)(X + o + 4); rsa[tile] = rstd[t0 + 32 * tile + r]; }
#pragma unroll
        for (int tile = 0; tile < 8; ++tile) {
            const int tt = t0 + 32 * tile; const f32x4 u0 = ua[tile], u1 = ub[tile]; const float rs = rsa[tile];
            const f32x4 v0 = {u0[0] * rs * g8[0], u0[1] * rs * g8[1], u0[2] * rs * g8[2], u0[3] * rs * g8[3]}, v1 = {u1[0] * rs * g8[4], u1[1] * rs * g8[5], u1[2] * rs * g8[6], u1[3] * rs * g8[7]};
            u32x4 aw; aw.x = pk2(v0[0], v0[1]); aw.y = pk2(v0[2], v0[3]); aw.z = pk2(v1[0], v1[1]); aw.w = pk2(v1[2], v1[3]);
            if (PASS == 2) { *(LAS f32x4*)(Us + r * 16 + 8 * hh) = v0; *(LAS f32x4*)(Us + r * 16 + 8 * hh + 4) = v1; }
            const bf16x8 af = __builtin_bit_cast(bf16x8, aw);
#pragma unroll
            for (int nbp = 0; nbp < 2; ++nbp) {
                f32x16 z;
#pragma unroll
                for (int i = 0; i < 16; ++i) z[i] = 0.f;
                const f32x16 xre = __builtin_amdgcn_mfma_f32_32x32x16_bf16(af, bfr[nbp], z, 0, 0, 0);
                const f32x16 xim = __builtin_amdgcn_mfma_f32_32x32x16_bf16(af, bfr[nbp + 2], z, 0, 0, 0);
#pragma unroll
                for (int i = 0; i < 16; ++i) Xw[crow(i, hh) * XR + 32 * nbp + r] = pk2(xre[i], xim[i]);
            }
            __builtin_amdgcn_fence(__ATOMIC_RELEASE, "wavefront"); __builtin_amdgcn_wave_barrier(); __builtin_amdgcn_fence(__ATOMIC_ACQUIRE, "wavefront");
#pragma unroll 1
            for (int tb = 0; tb < 32; tb += 8) {
                unsigned xw[8];
#pragma unroll
                for (int q = 0; q < 8; ++q) xw[q] = Xw[(tb + q) * XR + lane];
#pragma unroll
                for (int q = 0; q < 8; ++q) {
                    cmadd(lam[0], lam[1], hr, hi, __builtin_bit_cast(float, xw[q] << 16), __builtin_bit_cast(float, xw[q] & 0xffff0000u));
                    if (PASS == 2) Xw[(tb + q) * XR + lane] = pk2(hr, hi);
                }
            }
            if (PASS == 2) {
                __builtin_amdgcn_fence(__ATOMIC_RELEASE, "wavefront"); __builtin_amdgcn_wave_barrier(); __builtin_amdgcn_fence(__ATOMIC_ACQUIRE, "wavefront");
#pragma unroll
                for (int mb = 0; mb < 2; ++mb) {
                    f32x4 y = {0.f, 0.f, 0.f, 0.f};
#pragma unroll
                    for (int ks = 0; ks < 4; ++ks) { const bf16x8 a = *(const LAS bf16x8*)((const LAS char*)Xw + (16 * mb + l15) * (XR * 4) + (32 * ks + 8 * fq) * 2); y = __builtin_amdgcn_mfma_f32_16x16x32_bf16(a, cfr[ks], y, 0, 0, 0); }
#pragma unroll
                    for (int e = 0; e < 4; ++e) { const int tl = 16 * mb + 4 * fq + e; const size_t o = (size_t)(tt + tl) * D + 16 * g + l15;
                        c.p<unsigned char>(WS_G)[o] = (unsigned char)(__builtin_amdgcn_cvt_pk_fp8_f32(gelu_tanh(y[e] + dsk * Us[tl * 16 + l15]) * SC_G, 0.f, 0, false) & 0xff); }
                }
            }
            __builtin_amdgcn_fence(__ATOMIC_RELEASE, "wavefront"); __builtin_amdgcn_wave_barrier(); __builtin_amdgcn_fence(__ATOMIC_ACQUIRE, "wavefront");
        }
        if (PASS == 1) c.p<f32x2>(WS_SEND)[((size_t)chunk * 128 + g) * 64 + lane] = (f32x2){hr, hi};
    }
}


__device__ __forceinline__ void lds_test(const Ctx& c, LAS unsigned char* lds) {
    const int tid = threadIdx.x, lane = tid & 63, wid = tid >> 6, hh = lane >> 5, r = lane & 31;
    volatile LAS float* Xs = (volatile LAS float*)(lds + LDS_REG) + wid * (32 * XS_STRIDE);
    unsigned bad = 0;
    for (int it = 0; it < 2048; ++it) {
#pragma unroll
        for (int nb = 0; nb < 4; ++nb)
#pragma unroll
            for (int i = 0; i < 16; ++i) { const int row = crow(i, hh), col = 32 * nb + r; Xs[row * XS_STRIDE + col] = (float)(row * 131 + col * 7 + it + blockIdx.x); }
        __builtin_amdgcn_fence(__ATOMIC_RELEASE, "wavefront"); __builtin_amdgcn_wave_barrier(); __builtin_amdgcn_fence(__ATOMIC_ACQUIRE, "wavefront");
        for (int tau = 0; tau < 32; ++tau) {
            const float a = Xs[tau * XS_STRIDE + lane], b = Xs[tau * XS_STRIDE + 64 + lane];
            bad += (a != (float)(tau * 131 + lane * 7 + it + blockIdx.x)) + (b != (float)(tau * 131 + (64 + lane) * 7 + it + blockIdx.x));
        }
        __builtin_amdgcn_fence(__ATOMIC_RELEASE, "wavefront"); __builtin_amdgcn_wave_barrier(); __builtin_amdgcn_fence(__ATOMIC_ACQUIRE, "wavefront");
    }
    if (bad) atomicAdd(c.p<unsigned>(WS_CNT) + 512, bad);
}
__device__ __forceinline__ void p7_postproj(const Ctx& c, int gw, int nw, int tend) {
    const int tid = threadIdx.x, lane = tid & 63, wid = tid >> 6, l16 = lane & 15, sl = lane >> 4;
    const bf16_t* __restrict__ P = c.p<bf16_t>(WS_PROJ); const int* __restrict__ pos = (const int*)c.in[I_POS];
    if (gw >= tend) return;
    float gq[8], gk1[8], gk2[8];
#pragma unroll
    for (int j = 0; j < 8; ++j) { gq[j] = c.in[I_QG][8 * l16 + j]; gk1[j] = c.in[I_KG][128 + 8 * l16 + j]; gk2[j] = c.in[I_KG][256 + 8 * l16 + j]; }
    u32x4 raw[6], nraw[6]; unsigned short graw = 0, ngraw = 0; int pt = 0, npt = 0;
    auto loads = [&](int t, u32x4 (&r)[6], unsigned short& g, int& p) {
#pragma unroll
        for (int q = 0; q < 6; ++q) { const int sq = q < 4 ? q : (q == 4 ? 6 : 8); r[q] = *(const u32x4*)(P + (size_t)t * NSA_NP + (sq * 4 + sl) * 128 + 8 * l16); }
        g = P[(size_t)t * NSA_NP + 5120 + (lane < 48 ? lane : 0)]; p = pos[t];
    };
    loads(gw, raw, graw, pt);
    for (int t = gw; t < tend; t += nw) {
        const bool more = t + nw < tend;
        if (more) loads(t + nw, nraw, ngraw, npt);
        float cs[8], sn[8];
        { const float pf = (float)pt; const int ib = 8 * (l16 & 1);
#pragma unroll
          for (int j = 0; j < 8; ++j) { const float inv = fexp2(-(float)(ib + j) * (18.931568569324174f / 16.0f)); sincos_rev(pf * inv, sn[j], cs[j]); } }
#pragma unroll
        for (int q = 0; q < 6; ++q) {
            float v[8];
#pragma unroll
            for (int j = 0; j < 4; ++j) { v[2 * j] = __builtin_bit_cast(float, raw[q][j] << 16); v[2 * j + 1] = __builtin_bit_cast(float, raw[q][j] & 0xffff0000u); }
            float ss = 0.f;
#pragma unroll
            for (int j = 0; j < 8; ++j) ss += v[j] * v[j];
            ss += __shfl_xor(ss, 1); ss += __shfl_xor(ss, 2); ss += __shfl_xor(ss, 4); ss += __shfl_xor(ss, 8);
            const float rs = rsqrtf(ss * (1.0f / 128.0f) + RMS_EPS);
#pragma unroll
            for (int j = 0; j < 8; ++j) v[j] = v[j] * rs * (q < 4 ? gq[j] : (q == 4 ? gk1[j] : gk2[j]));
            float pv[8];
#pragma unroll
            for (int j = 0; j < 8; ++j) pv[j] = __shfl_xor(v[j], 2);
            if (l16 < 4) {
#pragma unroll
                for (int j = 0; j < 8; ++j) v[j] = (l16 < 2) ? (v[j] * cs[j] - pv[j] * sn[j]) : (v[j] * cs[j] + pv[j] * sn[j]);
            }
            if (q < 4) {
#pragma unroll
                for (int j = 0; j < 8; ++j) v[j] *= QSCALE;
            }
            u32x4 o; o.x = pk2(v[0], v[1]); o.y = pk2(v[2], v[3]); o.z = pk2(v[4], v[5]); o.w = pk2(v[6], v[7]);
            bf16_t* dst = q < 4 ? c.p<bf16_t>(WS_QN) + (size_t)t * D + (q * 4 + sl) * 128 : (bf16_t*)(c.ws + (q == 4 ? WS_KSL : WS_KW) + sl * KVH) + (size_t)t * 128;
            *(u32x4*)(dst + 8 * l16) = o;
        }
        if (lane < 48) c.p<float>(WS_GATES)[(size_t)t * 48 + lane] = sigmoidf_(bf2f(graw));
        if (more) {
#pragma unroll
            for (int q = 0; q < 6; ++q) raw[q] = nraw[q];
            graw = ngraw; pt = npt; }
    }
}

__device__ __forceinline__ void p9_cmpfinish(const Ctx& c, LAS unsigned char* lds) {
    const int tid = threadIdx.x, lane = tid & 63, wid = tid >> 6;
    LAS float* w2l = (LAS float*)(lds + LDS_REG);
    LAS float* hid = (LAS float*)(lds + LDS_REG + 131072) + wid * 256;
    const int* pos = (const int*)c.in[I_POS];
#pragma unroll 1
    for (int kv = 0; kv < 2; ++kv) {
        __syncthreads();
        { const float* w2 = c.in[kv ? I_CV2 : I_CK2];
          f32x4 wq[16];
#pragma unroll
          for (int q = 0; q < 16; ++q) wq[q] = *(const f32x4*)(w2 + (size_t)(tid + 512 * q) * 4);
#pragma unroll
          for (int q = 0; q < 16; ++q) *(LAS f32x4*)(w2l + (tid + 512 * q) * 4) = wq[q]; }
        __syncthreads();
        for (int row = blockIdx.x * 8 + wid; row < 2048; row += gridDim.x * 8) {
            const int h = row >> 9, n = row & 511;
            bf16_t* dst = (kv ? c.p<bf16_t>(WS_VCMP) : c.p<bf16_t>(WS_KCMP)) + ((size_t)h * NCMP + n) * 128;
            if (n == 511) { dst[lane] = 0; dst[lane + 64] = 0; continue; }
            const bf16_t* part = c.p<bf16_t>(WS_PART) + ((size_t)kv * 8 * 2048 + row) * 256 + 4 * lane;
            float a[4];
            { const u64* bacc = (const u64*)(c.ws + WS_CTL + 16384) + kv * 256 + 4 * lane;
#pragma unroll
              for (int q = 0; q < 4; ++q) a[q] = (float)((double)(long long)bacc[q] * (1.0 / 1099511627776.0)); }
            u32x2 pv[8];
#pragma unroll
            for (int kc = 0; kc < 8; ++kc) pv[kc] = *(const u32x2*)(part + (size_t)kc * 2048 * 256);
#pragma unroll
            for (int kc = 0; kc < 8; ++kc) { a[0] += __builtin_bit_cast(float, pv[kc][0] << 16); a[1] += __builtin_bit_cast(float, pv[kc][0] & 0xffff0000u); a[2] += __builtin_bit_cast(float, pv[kc][1] << 16); a[3] += __builtin_bit_cast(float, pv[kc][1] & 0xffff0000u); }
            *(LAS f32x4*)(hid + 4 * lane) = (f32x4){gelu_tanh(a[0]), gelu_tanh(a[1]), gelu_tanh(a[2]), gelu_tanh(a[3])};
            __builtin_amdgcn_fence(__ATOMIC_RELEASE, "wavefront"); __builtin_amdgcn_wave_barrier(); __builtin_amdgcn_fence(__ATOMIC_ACQUIRE, "wavefront");
            float o0 = 0.f, o1 = 0.f;
#pragma unroll 8
            for (int k = 0; k < 256; ++k) { const float hv = hid[k]; o0 += hv * w2l[k * 128 + lane]; o1 += hv * w2l[k * 128 + 64 + lane]; }
            __builtin_amdgcn_fence(__ATOMIC_RELEASE, "wavefront"); __builtin_amdgcn_wave_barrier(); __builtin_amdgcn_fence(__ATOMIC_ACQUIRE, "wavefront");
            if (kv == 0) {
                const float ss = wave_sum(o0 * o0 + o1 * o1); const float rs = rsqrtf(ss * (1.0f / 128.0f) + RMS_EPS);
                o0 = o0 * rs * c.in[I_KG][lane]; o1 = o1 * rs * c.in[I_KG][64 + lane];
                const float pvv = __shfl_xor(o0, 16);
                if (lane < 32) { const float pf = (float)pos[16 * n + 31]; const float inv = fexp2(-(float)(lane & 15) * (18.931568569324174f / 16.0f)); float sn, cs; sincos_rev(pf * inv, sn, cs);
                    o0 = (lane < 16) ? (o0 * cs - pvv * sn) : (o0 * cs + pvv * sn); }
            }
            dst[lane] = (bf16_t)f2bf(o0); dst[lane + 64] = (bf16_t)f2bf(o1);
        }
    }
}

constexpr int AT_STG = 32768, AT_VOF = 16384, AT_SB = 65536, AT_SE = AT_SB + 64 * 132 * 4, AT_SM = AT_SE + 64 * 132 * 4, AT_END = AT_SM + 64 * 16;
static_assert(LDS_REG + AT_END <= LDS_BYTES && 3 * AT_STG <= AT_SM, "attention LDS");
__device__ __forceinline__ int next_bit(unsigned long long lo, unsigned long long hi, int from) {
    if (from < 64) { const unsigned long long x = lo >> from; if (x) return from + __builtin_ctzll(x); from = 64; }
    if (from < 128) { const unsigned long long x = hi >> (from - 64); if (x) return from + __builtin_ctzll(x); }
    return 128;
}
__device__ __forceinline__ bool get_bit(unsigned long long lo, unsigned long long hi, int j) { return (((j < 64 ? lo : hi) >> (j & 63)) & 1ull) != 0ull; }
__device__ __forceinline__ void glds16(const void* gsrc, unsigned lds_dst) { unsigned keep;
    asm volatile("s_mov_b32 %0, m0\n\ts_mov_b32 m0, %2\n\ts_nop 0\n\tglobal_load_lds_dwordx4 %1, off\n\ts_mov_b32 m0, %0" : "=&s"(keep) : "v"(gsrc), "s"(lds_dst) : "memory"); }
template <int SRC, int OP, int NST>
__device__ __forceinline__ void attn_pass(LAS unsigned char* reg, const bf16_t* Kb, const bf16_t* Vb, unsigned long long mlo, unsigned long long mhi, unsigned long long flo, unsigned long long fhi,
                                          const bf16x8 (&qf)[8], int t_row, const unsigned long long smlo, const unsigned long long smhi, float lgs, f32x16 (&acc)[4], float& lsum, int tok_l,
                                          int st0, bool pre, const bf16_t* nK, const bf16_t* nV, int ntile, bool nWithV, int& st_next) {
    const int tid = threadIdx.x, lane = tid & 63, wid = __builtin_amdgcn_readfirstlane(tid >> 6), hh = lane >> 5, r = lane & 31;
    const int blk = (lane >> 4) & 1, q4l = (lane & 15) >> 2, p4 = lane & 3;
    constexpr int IPT = (OP == 1) ? 4 : 2;
    unsigned goK[2];
#pragma unroll
    for (int q = 0; q < 2; ++q) { const int row = 8 * wid + ((lane & 31) >> 2), ch = 4 * (2 * q + (lane >> 5)) + ((lane & 3) ^ ((row >> 2) & 3)); goK[q] = (unsigned)(row * 256 + ch * 16); }
    const unsigned ldsbase = (unsigned)(size_t)reg + (unsigned)(8 * wid) * 256u;
    int kb[2], vb[2];
#pragma unroll
    for (int q = 0; q < 2; ++q) {
        kb[q] = 2048 * (r >> 3) + 64 * (r & 7) + 16 * ((2 * q + hh) ^ ((r >> 2) & 3));
        vb[q] = 2048 * q + 64 * (4 * hh + q4l) + 16 * ((2 * blk + (p4 >> 1)) ^ (2 * q + hh)) + 8 * (p4 & 1);
    }
    auto issue_any = [&](const bf16_t* Kp, const bf16_t* Vp, int jj, int st, bool withV) {
        const char* kp = (const char*)Kp + (size_t)jj * 16384; const unsigned d = ldsbase + (unsigned)st * AT_STG;
        glds16(kp + goK[0], d); glds16(kp + goK[1], d + 1024u);
        if (withV) { const char* vp = (const char*)Vp + (size_t)jj * 16384; glds16(vp + goK[0], d + AT_VOF); glds16(vp + goK[1], d + AT_VOF + 1024u); }
    };
    auto issue = [&](int jj, int st) { issue_any(Kb, Vb, jj, st, OP == 1); };
    st_next = 0;
    int j = next_bit(mlo, mhi, 0);
    if (j >= 128) return;
    int jA = next_bit(mlo, mhi, j + 1), cnt = 0;
    if (!pre) issue(j, st0);
    if (NST == 3 && jA < 128) issue(jA, (st0 + 1) % 3);
    for (;;) {
        if (NST == 3 && jA < 128) { if (IPT == 4) asm volatile("s_waitcnt vmcnt(4)\n\ts_barrier" ::: "memory"); else asm volatile("s_waitcnt vmcnt(2)\n\ts_barrier" ::: "memory"); }
        else asm volatile("s_waitcnt vmcnt(0)\n\ts_barrier" ::: "memory");
        int jB = 128;
        const int st = (NST == 3) ? (st0 + cnt) % 3 : ((st0 + cnt) & 1);
        if (NST == 3) { if (jA < 128) { jB = next_bit(mlo, mhi, jA + 1); if (jB < 128) issue(jB, (st + 2) % 3); } }
        else { if (jA < 128) issue(jA, st ^ 1); }
        if (jA >= 128 && ntile >= 0) { st_next = (NST == 3) ? (st + 1) % 3 : (st ^ 1); issue_any(nK, nV, ntile, st_next, nWithV); }
        const LAS unsigned char* kl = reg + st * AT_STG; const LAS unsigned char* vl = kl + AT_VOF;
        const bool full = get_bit(flo, fhi, j);
        int kmin = 0, kmax = 63;
        if (!full) {
            if (SRC == 0) kmax = ((t_row - 31) >> 4) - 64 * j;
            else if (SRC == 1) kmax = t_row - 64 * j;
            else { kmax = t_row - 64 * j; kmin = t_row - 511 - 64 * j; }
        }
        float lg = lgs;
        if (SRC == 1) { const unsigned long long w = j < 64 ? smlo : smhi; if (!((w >> (j & 63)) & 1ull)) lg = -INFINITY; }
        kmin -= 4 * hh; kmax -= 4 * hh;
#pragma unroll
        for (int cc = 0; cc < 2; ++cc) {
            f32x16 S;
#pragma unroll
            for (int i = 0; i < 16; ++i) S[i] = lg;
#pragma unroll
            for (int ks = 0; ks < 8; ++ks) { const bf16x8 a = *(const LAS bf16x8*)(kl + kb[ks & 1] + 8192 * cc + 512 * (ks >> 1)); S = __builtin_amdgcn_mfma_f32_32x32x16_bf16(a, qf[ks], S, 0, 0, 0); }
            float p[16];
            if (full) {
#pragma unroll
                for (int i = 0; i < 16; ++i) p[i] = fexp2(S[i]);
            } else {
#pragma unroll
                for (int i = 0; i < 16; ++i) { const int kk = 32 * cc + (i & 3) + 8 * (i >> 2); p[i] = (kk >= kmin && kk <= kmax) ? fexp2(S[i]) : 0.f; }
            }
            if (OP == 0 || (OP == 1 && SRC != 0)) {
                float s = 0.f;
#pragma unroll
                for (int i = 0; i < 16; ++i) s += p[i];
                lsum += s;
            }
            if (OP == 1) {
#pragma unroll
                for (int s2 = 0; s2 < 2; ++s2) {
                    u32x4 pw;
#pragma unroll
                    for (int q = 0; q < 4; ++q) pw[q] = pk2(p[8 * s2 + 2 * q], p[8 * s2 + 2 * q + 1]);
                    const bf16x8 pb = __builtin_bit_cast(bf16x8, pw);
#pragma unroll
                    for (int db = 0; db < 4; ++db) {
                        const int vo = 8192 * cc + 4096 * s2 + 512 * db;
                        const s16x4 lo = __builtin_bit_cast(s16x4, __builtin_amdgcn_ds_read_tr16_b64_v4i16((LAS s16x4*)(vl + vb[0] + vo)));
                        const s16x4 hi = __builtin_bit_cast(s16x4, __builtin_amdgcn_ds_read_tr16_b64_v4i16((LAS s16x4*)(vl + vb[1] + vo)));
                        const bf16x8 vf = __builtin_shufflevector(lo, hi, 0, 1, 2, 3, 4, 5, 6, 7);
                        acc[db] = __builtin_amdgcn_mfma_f32_32x32x16_bf16(vf, pb, acc[db], 0, 0, 0);
                    }
                }
            }
            if (OP == 2) {
                LAS float* sb = (LAS float*)(reg + AT_SB) + tok_l * 132; LAS float* se = (LAS float*)(reg + AT_SE) + tok_l * 132;
#pragma unroll
                for (int q = 0; q < 4; ++q) {
                    float e0 = p[4 * q]; float v = e0 + 2.0f * (p[4 * q + 1] + p[4 * q + 2] + p[4 * q + 3]);
                    v += __shfl_xor(v, 1); v += __shfl_xor(v, 2); e0 += __shfl_xor(e0, 1); e0 += __shfl_xor(e0, 2);
                    const int js = 16 * j + 8 * cc + 2 * q + hh;
                    if ((r & 3) == 0) { sb[js] = v; se[js] = e0; }
                }
            }
        }
        if (jA >= 128) break;
        j = jA; jA = (NST == 3) ? jB : next_bit(mlo, mhi, jA + 1); ++cnt;
    }
    asm volatile("s_waitcnt lgkmcnt(0)\n\ts_barrier" ::: "memory");
}

__device__ __forceinline__ void p10_attention(const Ctx& c, LAS unsigned char* lds) {
    LAS unsigned char* reg = lds + LDS_REG;
    const int tid = threadIdx.x, lane = tid & 63, wid = tid >> 6, hh = lane >> 5, r = lane & 31;
    LAS int* qslot = (LAS int*)(lds + LDS_TAB + 112);
    __syncthreads();
    if (tid == 0) *qslot = (int)atomicAdd(c.p<unsigned>(WS_CNT) + 1024, 1u);
    __syncthreads();
    for (;;) {
        {
            const int idx = *qslot;
            if (idx >= 512) break;
            int nidx = 0;
            if (tid == 0) nidx = (int)atomicAdd(c.p<unsigned>(WS_CNT) + 1024, 1u);
            const int U = idx, h = U & 3, tile = 127 - (U >> 2), t0 = tile * 64, cur = tile;
            const int tok_l = 8 * wid + (r >> 2), t_row = t0 + tok_l, head = 4 * h + (r & 3);
            bf16x8 qf[8];
#pragma unroll
            for (int ks = 0; ks < 8; ++ks) qf[ks] = *(const bf16x8*)(c.p<bf16_t>(WS_QN) + (size_t)t_row * D + head * 128 + 16 * ks + 8 * hh);
            const float* gt = c.p<float>(WS_GATES) + (size_t)t_row * 48 + head;
            const float gc = gt[0], gs = gt[16], gw = gt[32];
            const bf16_t* Kc = c.p<bf16_t>(WS_KCMP) + (size_t)h * NCMP * 128; const bf16_t* Vc = c.p<bf16_t>(WS_VCMP) + (size_t)h * NCMP * 128;
            const bf16_t* Ks = (const bf16_t*)(c.ws + WS_KSL + h * KVH); const bf16_t* Vs = (const bf16_t*)(c.ws + WS_VSL + h * KVH);
            const bf16_t* Kw = (const bf16_t*)(c.ws + WS_KW + h * KVH); const bf16_t* Vw = (const bf16_t*)(c.ws + WS_VW + h * KVH);
            f32x16 acc[4];
#pragma unroll
            for (int db = 0; db < 4; ++db)
#pragma unroll
                for (int i = 0; i < 16; ++i) acc[db][i] = 0.f;
            unsigned long long smlo = 0ull, smhi = 0ull;
            const int ntc = (((t0 + 32) >> 4) >> 6) + 1;
            const unsigned long long mclo = (1ull << ntc) - 1ull;
            const int nfc = t0 >= 31 ? ((((t0 - 31) >> 4) + 1) >> 6) : 0;
            const unsigned long long fclo = (1ull << nfc) - 1ull;
            float lc = 0.f, dummy = 0.f;
            int rst = 0;
            attn_pass<0, 0, 2>(reg, Kc, Vc, mclo, 0ull, fclo, 0ull, qf, t_row, smlo, smhi, 0.f, acc, lc, tok_l, 0, false, Kc, Vc, 0, false, rst);
            lc += __shfl_xor(lc, 32);
            const float lg_lc = -__builtin_amdgcn_logf(fmaxf(lc, 1e-30f));
            { const int s0 = rst; attn_pass<0, 2, 2>(reg, Kc, Vc, mclo, 0ull, fclo, 0ull, qf, t_row, smlo, smhi, lg_lc, acc, dummy, tok_l, s0, true, Ks, Vs, 0, true, rst); }
            __syncthreads();
            {
                const int nforced = cur >= 2 ? 3 : cur + 1, nrem = 16 - nforced, ncand = cur - 2 > 0 ? cur - 2 : 0;
                for (int tk = 0; tk < 8; ++tk) {
                    const int tl = 8 * wid + tk;
                    const LAS float* sb = (const LAS float*)(reg + AT_SB) + tl * 132; const LAS float* se = (const LAS float*)(reg + AT_SE) + tl * 132;
                    const int j0 = lane, j1 = lane + 64;
                    const bool c0 = (j0 >= 1) && (j0 <= cur - 2), c1 = (j1 <= cur - 2);
                    float s0 = c0 ? sb[j0] + se[j0 + 1] : -INFINITY;
                    float s1 = c1 ? sb[j1] + (j1 + 1 < 128 ? se[j1 + 1] : 0.f) : -INFINITY;
                    bool selA = false, selB = false;
                    if (ncand <= nrem) { selA = c0; selB = c1; }
                    else {
                        const unsigned u0 = __builtin_bit_cast(unsigned, s0), u1 = __builtin_bit_cast(unsigned, s1);
                        unsigned thr = 0u;
                        for (int b = 30; b >= 0; --b) { const unsigned cand = thr | (1u << b);
                            const int cn = __builtin_popcountll(__ballot(c0 && u0 >= cand)) + __builtin_popcountll(__ballot(c1 && u1 >= cand)); if (cn >= nrem) thr = cand; }
                        const bool g0 = c0 && u0 > thr, g1 = c1 && u1 > thr, e0 = c0 && u0 == thr, e1 = c1 && u1 == thr;
                        const int need = nrem - (__builtin_popcountll(__ballot(g0)) + __builtin_popcountll(__ballot(g1)));
                        const unsigned long long be0 = __ballot(e0), be1 = __ballot(e1), lt = (1ull << lane) - 1ull;
                        const int r0 = __builtin_popcountll(be0 & lt), r1 = __builtin_popcountll(be0) + __builtin_popcountll(be1 & lt);
                        selA = g0 || (e0 && r0 < need); selB = g1 || (e1 && r1 < need);
                    }
                    if (j0 == 0 || j0 == cur || j0 == cur - 1) selA = true;
                    if (j1 == cur || j1 == cur - 1) selB = true;
                    const unsigned long long b0 = __ballot(selA), b1 = __ballot(selB);
                    if (lane == 0) { LAS unsigned* smw = (LAS unsigned*)(reg + AT_SM) + tl * 4; smw[0] = (unsigned)b0; smw[1] = (unsigned)(b0 >> 32); smw[2] = (unsigned)b1; smw[3] = (unsigned)(b1 >> 32); }
                }
            }
            __syncthreads();
            unsigned long long ulo, uhi;
            {
                const LAS unsigned* smw = (const LAS unsigned*)(reg + AT_SM);
                unsigned a0 = smw[lane * 4], a1 = smw[lane * 4 + 1], a2 = smw[lane * 4 + 2], a3 = smw[lane * 4 + 3];
#pragma unroll
                for (int o = 1; o < 64; o <<= 1) { a0 |= __shfl_xor(a0, o); a1 |= __shfl_xor(a1, o); a2 |= __shfl_xor(a2, o); a3 |= __shfl_xor(a3, o); }
                a0 = __builtin_amdgcn_readfirstlane(a0); a1 = __builtin_amdgcn_readfirstlane(a1); a2 = __builtin_amdgcn_readfirstlane(a2); a3 = __builtin_amdgcn_readfirstlane(a3);
                ulo = (unsigned long long)a0 | ((unsigned long long)a1 << 32); uhi = (unsigned long long)a2 | ((unsigned long long)a3 << 32);
                smlo = (unsigned long long)smw[tok_l * 4] | ((unsigned long long)smw[tok_l * 4 + 1] << 32); smhi = (unsigned long long)smw[tok_l * 4 + 2] | ((unsigned long long)smw[tok_l * 4 + 3] << 32);
            }
            __syncthreads();
            unsigned long long fslo, fshi;
            if (cur >= 64) { fslo = ~0ull; fshi = (1ull << (cur - 64)) - 1ull; } else { fslo = (1ull << cur) - 1ull; fshi = 0ull; }
            float ls = 0.f;
            { const int s0 = rst; attn_pass<1, 1, 3>(reg, Ks, Vs, ulo, uhi, fslo, fshi, qf, t_row, smlo, smhi, 0.f, acc, ls, tok_l, s0, true, Kc, Vc, 0, true, rst); }
            ls += __shfl_xor(ls, 32);
            { const float f = gs / fmaxf(ls, 1e-30f);
#pragma unroll
              for (int db = 0; db < 4; ++db) acc[db] = acc[db] * f; }
            const int jlo = cur - 8 > 0 ? cur - 8 : 0;
            { const int s0 = rst; attn_pass<0, 1, 3>(reg, Kc, Vc, mclo, 0ull, fclo, 0ull, qf, t_row, smlo, smhi, lg_lc + __builtin_amdgcn_logf(gc), acc, dummy, tok_l, s0, true, Kw, Vw, jlo, true, rst); }
            unsigned long long mwlo = 0ull, mwhi = 0ull, fwlo = 0ull, fwhi = 0ull;
            for (int jj = jlo; jj <= cur; ++jj) { const bool fl = (jj >= cur - 7) && (jj <= cur - 1);
                if (jj < 64) { mwlo |= 1ull << jj; if (fl) fwlo |= 1ull << jj; } else { mwhi |= 1ull << (jj - 64); if (fl) fwhi |= 1ull << (jj - 64); } }
            f32x4* stash = (f32x4*)(c.ws + WS_PART) + (size_t)blockIdx.x * (16 * 512) + tid;
#pragma unroll
            for (int db = 0; db < 4; ++db)
#pragma unroll
                for (int q = 0; q < 4; ++q) { stash[(db * 4 + q) * 512] = (f32x4){acc[db][4 * q], acc[db][4 * q + 1], acc[db][4 * q + 2], acc[db][4 * q + 3]}; }
#pragma unroll
            for (int db = 0; db < 4; ++db)
#pragma unroll
                for (int i = 0; i < 16; ++i) acc[db][i] = 0.f;
            float lw = 0.f;
            { const int s0 = rst; attn_pass<2, 1, 3>(reg, Kw, Vw, mwlo, mwhi, fwlo, fwhi, qf, t_row, smlo, smhi, 0.f, acc, lw, tok_l, s0, true, Kw, Vw, -1, false, rst); }
            lw += __shfl_xor(lw, 32);
            { const float f = gw / fmaxf(lw, 1e-30f);
#pragma unroll
              for (int db = 0; db < 4; ++db)
#pragma unroll
                  for (int q = 0; q < 4; ++q) { const f32x4 a = stash[(db * 4 + q) * 512];
#pragma unroll
                      for (int e = 0; e < 4; ++e) acc[db][4 * q + e] = a[e] + acc[db][4 * q + e] * f; } }
            unsigned char* orow = c.ws + WS_O + (size_t)t_row * D + head * 128;
#pragma unroll
            for (int db = 0; db < 4; ++db)
#pragma unroll
                for (int q = 0; q < 4; ++q) { int w = 0; w = __builtin_amdgcn_cvt_pk_fp8_f32(acc[db][4 * q] * SC_O, acc[db][4 * q + 1] * SC_O, w, false); w = __builtin_amdgcn_cvt_pk_fp8_f32(acc[db][4 * q + 2] * SC_O, acc[db][4 * q + 3] * SC_O, w, true);
                    *(unsigned*)(orow + 32 * db + 8 * q + 4 * hh) = (unsigned)w; }
            __syncthreads();
            if (tid == 0) *qslot = nidx;
            __syncthreads();
        }
    }
}

__device__ __forceinline__ void p12_router(const Ctx& c, LAS unsigned char* lds) {
    const int tid = threadIdx.x, lane = tid & 63, wid = tid >> 6;
    const bf16_t* H3 = c.p<bf16_t>(WS_H3B); const float* gain = c.in[I_NFFN] + D; const float* wr = c.in[I_WR];
    LAS float* wl = (LAS float*)(lds + LDS_REG);
#pragma unroll
    for (int q = 0; q < D * 2 / 512; ++q) { const int i = tid + 512 * q, k = i >> 1; f32x4 w = *(const f32x4*)(wr + (size_t)i * 4); const float gk = gain[k]; *(LAS f32x4*)(wl + i * 4) = w * gk; }
    __syncthreads();
    int pt = -1, pe0 = 0, pe1 = 0, pp0 = 0, pp1 = 0; float pw0 = 0.f, pw1 = 0.f, prs = 0.f;
    auto flush = [&]() {
        if (lane == 0 && pt >= 0) { const int d0 = pe0 * L + pp0, d1 = pe1 * L + pp1;
            c.p<int>(WS_ROWTOK)[d0] = pt; c.p<int>(WS_ROWTOK)[d1] = pt; c.p<float>(WS_ROWW)[d0] = pw0; c.p<float>(WS_ROWW)[d1] = pw1; c.p<float>(WS_ROWRS)[d0] = prs; c.p<float>(WS_ROWRS)[d1] = prs; c.p<int>(WS_TOKD)[2 * pt] = d0; c.p<int>(WS_TOKD)[2 * pt + 1] = d1; }
    };
    for (int t = blockIdx.x * 8 + wid; t < L; t += gridDim.x * 8) {
        float lg[8];
#pragma unroll
        for (int e = 0; e < 8; ++e) lg[e] = 0.f;
#pragma unroll 16
        for (int i = 0; i < 32; ++i) { const int k = lane + 64 * i; const float hvv = bf2f(H3[(size_t)t * D + k]); const f32x4 w0 = *(const LAS f32x4*)(wl + k * 8), w1 = *(const LAS f32x4*)(wl + k * 8 + 4);
#pragma unroll
            for (int e = 0; e < 4; ++e) { lg[e] += hvv * w0[e]; lg[4 + e] += hvv * w1[e]; } }
        const float rs = ss_rstd(c.p<u64>(WS_SS3) + t);
#pragma unroll
        for (int e = 0; e < 8; ++e) lg[e] = wave_sum(lg[e]) * rs + c.in[I_BR][e];
        if (lane == 0) {
            int e0 = 0; float v0 = lg[0];
#pragma unroll
            for (int e = 1; e < 8; ++e) if (lg[e] > v0) { v0 = lg[e]; e0 = e; }
            int e1 = -1; float v1 = -INFINITY;
#pragma unroll
            for (int e = 0; e < 8; ++e) if (e != e0 && lg[e] > v1) { v1 = lg[e]; e1 = e; }
            const float w0 = 1.0f / (1.0f + __expf(v1 - v0)), w1 = 1.0f - w0;
            unsigned* cnt = c.p<unsigned>(WS_CNT);
            flush();
            pp0 = (int)atomicAdd(cnt + e0 * 64, 1u); pp1 = (int)atomicAdd(cnt + e1 * 64, 1u);
            pt = t; pe0 = e0; pe1 = e1; pw0 = w0; pw1 = w1; prs = rs;
        }
    }
    flush();
}
__device__ __forceinline__ void moe_tables(const Ctx& c, LAS unsigned char* lds) {
    LAS int* tab = (LAS int*)(lds + LDS_TAB);
    if (threadIdx.x == 0) { int s = 0; for (int e = 0; e < NE; ++e) { const int n = (int)((c.p<unsigned>(WS_CNT)[e * 64] + 255u) >> 8); tab[e] = e * (L / 256); tab[8 + e] = n; tab[17 + e] = s; s += n; } tab[16] = s; }
    __syncthreads();
}
__device__ __forceinline__ void p13_scatter(const Ctx& c, LAS unsigned char* lds) {
    const LAS int* tab = (const LAS int*)(lds + LDS_TAB);
    for (int i = blockIdx.x * 512 + threadIdx.x; i < 2 * L; i += gridDim.x * 512) {
        const int e = c.p<int>(WS_TOKE)[i], dest = tab[e] * 256 + c.p<int>(WS_TOKP)[i];
        c.p<int>(WS_ROWTOK)[dest] = i >> 1; c.p<float>(WS_ROWW)[dest] = c.p<float>(WS_TOKW)[i]; c.p<int>(WS_TOKD)[i] = dest;
    }
}
template <bool GATHER> struct MoeSched {
    const LAS int* tab; int npn, G, cidx; const char* A; const char* B; unsigned lda, ldb; size_t bexp; const int* rowtok;
    __device__ __forceinline__ int total() const { return __builtin_amdgcn_readfirstlane(tab[16]) * npn; }
    __device__ __forceinline__ int nfull() const { return GATHER ? (1 << 30) : (total() / G) * G; }
    __device__ __forceinline__ bool split() const { const int r = total() - nfull(); return !GATHER && r > 0 && r * 4 <= G && r <= 64; }
    __device__ __forceinline__ void decode(int Lx, pg8::Unit& u) const {
        int e = 0;
#pragma unroll
        for (int q = 1; q < NE; ++q) if (Lx >= __builtin_amdgcn_readfirstlane(tab[17 + q]) * npn) e = q;
        const int te = __builtin_amdgcn_readfirstlane(tab[e]), nb = __builtin_amdgcn_readfirstlane(tab[8 + e]);
        const int rem = Lx - __builtin_amdgcn_readfirstlane(tab[17 + e]) * npn, pn = rem / nb;
        u.pm = te + (rem - pn * nb); u.pn = e * (npn) + pn; u.ax = pn;
    }
    __device__ __forceinline__ bool next(int i, pg8::Unit& u) const {
        const int Lx = i * G + cidx, tot = total();
        if (!GATHER && split() && Lx >= nfull()) {
            const int r = tot - nfull(), sh = (r * 8 <= G) ? 3 : 2;
            const int q = Lx - nfull(); if (q >= (r << sh)) return false;
            decode(nfull() + (q >> sh), u); u.ax |= ((q & ((1 << sh) - 1)) + 1) << 8 | (sh == 3 ? 1 << 12 : 0) | (q >> sh) << 16; return true;
        }
        if (Lx >= tot) return false;
        decode(Lx, u); return true;
    }
    __device__ __forceinline__ int ksub(const pg8::Unit& u) const { return (u.ax >> 8) & 15; }
    __device__ __forceinline__ int kstart(const pg8::Unit& u) const { const int q = ksub(u); if (q == 0) return 0;
        if (u.ax & (1 << 12)) return q <= 7 ? 6 * (q - 1) : 40;
        return q <= 1 ? 0 : q == 2 ? 12 : q == 3 ? 24 : 34; }
    __device__ __forceinline__ int unit_nt(const pg8::Unit& u, int nt) const { const int q = ksub(u); if (GATHER || q == 0) return nt;
        if (u.ax & (1 << 12)) return q <= 6 ? 6 : 4;
        return q <= 2 ? 12 : 10; }
    __device__ __forceinline__ const char* a_base(const pg8::Unit& u) const { return GATHER ? A : A + (size_t)u.pm * 256 * lda + (size_t)kstart(u) * 128; }
    __device__ __forceinline__ const char* b_base(const pg8::Unit& u) const { return B + (size_t)(u.pn / npn) * bexp + (size_t)(u.ax & 255) * 256 * ldb + (GATHER ? 0 : (size_t)kstart(u) * 128); }
    __device__ __forceinline__ void a_rows(const pg8::Unit& u, const int (&R)[2], unsigned (&o)[2][2]) const {
#pragma unroll
        for (int h = 0; h < 2; ++h)
#pragma unroll
            for (int i = 0; i < 2; ++i) o[h][i] = GATHER ? (unsigned)rowtok[u.pm * 256 + h * 128 + R[i]] * lda : (unsigned)(h * 128 + R[i]) * lda;
    }
};
struct CmpSched {
    int G, cidx; const unsigned char* ws;
    __device__ __forceinline__ int unit_nt(const pg8::Unit&, int nt) const { return nt; }
    __device__ __forceinline__ bool next(int i, pg8::Unit& u) const { const int Lx = i * G + cidx; if (Lx >= 128) return false; u.pm = Lx & 7; u.pn = (Lx >> 3) & 7; u.ax = (Lx >> 6) * 8 + u.pn; return true; }
    __device__ __forceinline__ const char* a_base(const pg8::Unit& u) const { const int kv = u.ax >> 3, h = u.pm >> 1, n0 = (u.pm & 1) * 256;
        return (const char*)ws + (kv ? WS_VC : WS_KC) + h * KVH + (size_t)n0 * 4096 + (size_t)u.pn * 1024; }
    __device__ __forceinline__ const char* b_base(const pg8::Unit& u) const { return (const char*)ws + ((u.ax >> 3) ? WS_CV1 : WS_CK1) + (size_t)u.pn * 1024; }
    __device__ __forceinline__ void a_rows(const pg8::Unit&, const int (&R)[2], unsigned (&o)[2][2]) const {
#pragma unroll
        for (int h = 0; h < 2; ++h)
#pragma unroll
            for (int i = 0; i < 2; ++i) o[h][i] = (unsigned)(h * 128 + R[i]) * 4096u;
    }
};
__device__ __forceinline__ void p16_combine(const Ctx& c, LAS unsigned char* lds) {
    const bf16_t* H3 = c.p<bf16_t>(WS_H3B); const bf16_t* YR = c.p<bf16_t>(WS_YR); const int* td = c.p<int>(WS_TOKD);
    const LAS int* tab = (const LAS int*)(lds + LDS_TAB);
    const int tot = tab[16] * 8, nfull = (tot / (int)gridDim.x) * (int)gridDim.x, rem = tot - nfull; const bool split = rem > 0 && rem * 4 <= (int)gridDim.x && rem <= 64; const int nsp = (rem * 8 <= (int)gridDim.x) ? 8 : 4;
    for (int i = blockIdx.x * 512 + threadIdx.x; i < L * (D / 8); i += gridDim.x * 512) {
        const int t = i >> 8, c8 = (i & 255) * 8, pn = c8 >> 8; const size_t o = (size_t)t * D + c8;
        const u32x4 hb = *(const u32x4*)(H3 + o);
        f32x4 o0 = {__builtin_bit_cast(float, hb[0] << 16), __builtin_bit_cast(float, hb[0] & 0xffff0000u), __builtin_bit_cast(float, hb[1] << 16), __builtin_bit_cast(float, hb[1] & 0xffff0000u)};
        f32x4 o1 = {__builtin_bit_cast(float, hb[2] << 16), __builtin_bit_cast(float, hb[2] & 0xffff0000u), __builtin_bit_cast(float, hb[3] << 16), __builtin_bit_cast(float, hb[3] & 0xffff0000u)};
        const int d0 = td[2 * t], d1 = td[2 * t + 1];
        const u32x4 a = *(const u32x4*)(YR + (size_t)d0 * D + c8), b = *(const u32x4*)(YR + (size_t)d1 * D + c8);
        bool via0 = true, via1 = true;
        if (split) {
#pragma unroll
            for (int k = 0; k < 2; ++k) {
                const int d = k ? d1 : d0, rt = d >> 8, e = rt >> 5, Lu = tab[17 + e] * 8 + pn * tab[8 + e] + (rt & 31);
                if (Lu >= nfull) {
                    if (k) via1 = false; else via0 = false;
#pragma unroll
                    for (int sgm = 0; sgm < 8; ++sgm) { if (sgm >= nsp) break; const u32x4 pv = *(const u32x4*)(c.p<bf16_t>(WS_PART) + ((size_t)(sgm * 64 + (Lu - nfull)) * 256 + (d & 255)) * 256 + (c8 & 255));
#pragma unroll
                        for (int q = 0; q < 2; ++q) { o0[2 * q] += __builtin_bit_cast(float, pv[q] << 16); o0[2 * q + 1] += __builtin_bit_cast(float, pv[q] & 0xffff0000u); o1[2 * q] += __builtin_bit_cast(float, pv[2 + q] << 16); o1[2 * q + 1] += __builtin_bit_cast(float, pv[2 + q] & 0xffff0000u); } }
                }
            }
        }
        if (via0) {
#pragma unroll
            for (int q = 0; q < 2; ++q) { o0[2 * q] += __builtin_bit_cast(float, a[q] << 16); o0[2 * q + 1] += __builtin_bit_cast(float, a[q] & 0xffff0000u); o1[2 * q] += __builtin_bit_cast(float, a[2 + q] << 16); o1[2 * q + 1] += __builtin_bit_cast(float, a[2 + q] & 0xffff0000u); } }
        if (via1) {
#pragma unroll
            for (int q = 0; q < 2; ++q) { o0[2 * q] += __builtin_bit_cast(float, b[q] << 16); o0[2 * q + 1] += __builtin_bit_cast(float, b[q] & 0xffff0000u); o1[2 * q] += __builtin_bit_cast(float, b[2 + q] << 16); o1[2 * q + 1] += __builtin_bit_cast(float, b[2 + q] & 0xffff0000u); } }
        *(f32x4*)(c.out + o) = o0; *(f32x4*)(c.out + o + 4) = o1;
    }
}
__device__ __forceinline__ void copy_out(const Ctx& c, const float* src) {
    for (int i = blockIdx.x * 512 + threadIdx.x; i < L * D / 4; i += gridDim.x * 512) ((f32x4*)c.out)[i] = ((const f32x4*)src)[i];
}


__device__ __forceinline__ void dump_out(const Ctx& c) {
    for (size_t i = (size_t)blockIdx.x * 512 + threadIdx.x; i < (size_t)L * D; i += (size_t)gridDim.x * 512) {
        float v = 0.f;
        if (MK_LAST_PHASE <= 2) {
            if (i < 524288) v = (float)(c.p<unsigned>(WS_SEND)[i] & 0xFFFu);
            else if (i < 524288 + 16384) v = 0.f;
            else if (i < 524288 + 16384 + 8192) v = 0.f;

        } else v = bf2f(c.p<bf16_t>(MK_LAST_PHASE == 3 ? WS_G : MK_LAST_PHASE == 4 ? WS_H1B : MK_LAST_PHASE == 5 ? WS_ACT1 : MK_LAST_PHASE == 6 ? WS_H2B : WS_PROJ)[i]);
        c.out[i] = v;
    }
}
#if defined(__HIP_DEVICE_COMPILE__)
#define MK_NO_PK __attribute__((target("no-packed-fp32-ops")))
#else
#define MK_NO_PK
#endif
__global__ void __launch_bounds__(512, 2) MK_NO_PK fwd_kernel(Args args) {
    extern __shared__ __attribute__((aligned(256))) unsigned char lds_raw[];
    LAS unsigned char* lds = (LAS unsigned char*)lds_raw;
    Ctx c;
#pragma unroll
    for (int i = 0; i < 29; ++i) c.in[i] = args.in[i];
    c.out = args.out; c.ws = args.ws;
    if (threadIdx.x == 0) *(LAS u32x4*)(lds + LDS_BAR) = (u32x4){0u, 0u, 0u, 0u};
    __syncthreads();
    const XcdBarrier bar = xcd_barrier_post((unsigned*)(args.ws + WS_CTL), (volatile LAS unsigned*)(lds + LDS_BAR));
    const int lo = args.ph_lo, hi = args.ph_hi;
    LAS unsigned char* greg = lds + LDS_REG;
#ifndef MK_PHASE_MASK
#define MK_PHASE_MASK 0xFFFFFFu
#endif
#ifndef MK_NCONV
#define MK_NCONV 8u
#endif
#define PHASE(k) if (((MK_PHASE_MASK >> (k)) & 1u) && lo <= (k) && (k) < hi) { if ((k) > lo) xcd_barrier(bar);
#define ENDPHASE }
#ifndef MK_DUP
#define MK_DUP -1
#endif
    PHASE(0) p0_prologue(c, lds); if (MK_DUP == 0) p0_prologue(c, lds); ENDPHASE
    PHASE(1) s5_pass<1>(c, lds); if (MK_DUP == 1) s5_pass<1>(c, lds); ENDPHASE
    PHASE(2) s5_pass<2>(c, lds); if (MK_DUP == 1) s5_pass<2>(c, lds); ENDPHASE
    PHASE(3) { pg8::DenseSched S; S.so.init(32, 16, gridDim.x, blockIdx.x, 16); S.A = (const char*)c.p<bf16_t>(WS_G); S.B = (const char*)c.p<bf16_t>(WS_WGLU); S.lda = 2048; S.ldb = 2048;
               pg8::EpiGLU E{c.in[I_X], c.p<float>(WS_H1), c.p<bf16_t>(WS_H1B), c.p<u64>(WS_SS1), 1.0f / (SC_G * SC_W)}; pg8::gemm_phase<pg8::EpiGLU, pg8::DenseSched, true>(greg, S, E, 16, 2048u); } ENDPHASE
    PHASE(4) { pg8::DenseSched S; S.so.init(32, 44, gridDim.x, blockIdx.x); S.A = (const char*)c.p<bf16_t>(WS_H1B); S.B = (const char*)c.p<bf16_t>(WS_WGU); S.lda = 4096; S.ldb = 4096;
               pg8::EpiSwiGLU<false> E{c.p<bf16_t>(WS_ACT1), c.p<u64>(WS_SS1), nullptr, 1.0f, {}, {}}; pg8::gemm_phase(greg, S, E, 32, 4096u);
               if (gridDim.x == 256u && blockIdx.x >= 128u) { __syncthreads(); late_convert(c, lds, (int)((blockIdx.x - 128u) * 8u + (threadIdx.x >> 6)), 1024); } } ENDPHASE
    PHASE(5) { pg8::DenseSched S; S.so.init(32, 8, gridDim.x, blockIdx.x); S.A = (const char*)c.p<bf16_t>(WS_ACT1); S.B = (const char*)c.p<bf16_t>(WS_WDN); S.lda = DFF * 2; S.ldb = DFF * 2;
               pg8::EpiResid E{c.p<bf16_t>(WS_H1B), nullptr, c.p<bf16_t>(WS_H2B), c.p<u64>(WS_SS2), c.ws + WS_H2F8, 1.0f}; pg8::gemm_phase(greg, S, E, 88, (unsigned)(DFF * 2)); } ENDPHASE
    PHASE(6) { pg8::DenseSched S; S.so.init(32, 21, gridDim.x, blockIdx.x, 16); S.A = (const char*)(c.ws + WS_H2F8); S.B = (const char*)c.p<bf16_t>(WS_WIN); S.lda = 2048; S.ldb = 2048;
               pg8::EpiProj E{c.p<bf16_t>(WS_PROJ), c.p<u64>(WS_SS2), NSA_NP, 1.0f / (SC_H * SC_W), c.ws}; pg8::gemm_phase<pg8::EpiProj, pg8::DenseSched, true>(greg, S, E, 16, 2048u); } ENDPHASE
    PHASE(8) { CmpSched S{(int)gridDim.x, (int)blockIdx.x, c.ws}; pg8::EpiPart E{c.p<float>(WS_PART)}; pg8::gemm_phase(greg, S, E, 8, 8192u);
               { const int w8 = (int)(threadIdx.x >> 6);
                 if (gridDim.x == 256u) { if (blockIdx.x < 128u) p7_postproj(c, (int)blockIdx.x * 8 + w8, 1024, 1024); else p7_postproj(c, 1024 + (int)(blockIdx.x - 128u) * 8 + w8, 1024, L); }
                 else p7_postproj(c, (int)blockIdx.x * 8 + w8, (int)gridDim.x * 8, L); } } ENDPHASE
    PHASE(9) p9_cmpfinish(c, lds); if (MK_DUP == 7) p9_cmpfinish(c, lds); ENDPHASE
    PHASE(10) {
                const bool grp = (gridDim.x & 31u) == 0u;
                if (grp) { if (((blockIdx.x >> 3) & 3u) == 3u) { moe_convert(c, lds, (int)(((blockIdx.x >> 5) * 8u + (blockIdx.x & 7u)) * 8u + (threadIdx.x >> 6)), (int)((gridDim.x >> 5) * 64u)); __syncthreads(); } }
                else { moe_convert(c, lds, (int)(blockIdx.x * 8u + (threadIdx.x >> 6)), (int)(gridDim.x * 8u)); __syncthreads(); }
                p10_attention(c, lds);
                moe_convert_queue(c); } ENDPHASE
    PHASE(11) { pg8::DenseSched S; S.so.init(32, 8, gridDim.x, blockIdx.x); S.A = (const char*)(c.ws + WS_O); S.B = (const char*)c.p<bf16_t>(WS_WOUT); S.lda = 2048; S.ldb = 2048;
                pg8::EpiResid E{c.p<bf16_t>(WS_H2B), nullptr, c.p<bf16_t>(WS_H3B), c.p<u64>(WS_SS3), c.ws + WS_H3F8, 1.0f / (SC_O * SC_W)}; pg8::gemm_phase<pg8::EpiResid, pg8::DenseSched, true>(greg, S, E, 16, 2048u); } ENDPHASE
    PHASE(12) p12_router(c, lds); ENDPHASE
    PHASE(14) { moe_tables(c, lds);
                MoeSched<true> S{(const LAS int*)(lds + LDS_TAB), 44, (int)gridDim.x, (int)(((gridDim.x & 7u) == 0u) ? ((blockIdx.x & 7u) * (gridDim.x >> 3) + (blockIdx.x >> 3)) : blockIdx.x), (const char*)(c.ws + WS_H3F8), (const char*)(c.ws + WS_MGU), 2048u, 2048u, (size_t)11264 * 2048, c.p<int>(WS_ROWTOK)};
                pg8::EpiSwiGLU<true> E{c.p<bf16_t>(WS_ACT2), c.p<u64>(WS_SS3), c.p<float>(WS_ROWRS), 1.0f / (SC_H * SC_W), {}, {}}; pg8::gemm_phase<pg8::EpiSwiGLU<true>, MoeSched<true>, true>(greg, S, E, 16, 2048u); if (MK_DUP == 14) { __syncthreads(); pg8::gemm_phase<pg8::EpiSwiGLU<true>, MoeSched<true>, true>(greg, S, E, 16, 2048u); } } ENDPHASE
    PHASE(15) { if (lo == 15) moe_tables(c, lds);
                MoeSched<false> S{(const LAS int*)(lds + LDS_TAB), 8, (int)gridDim.x, (int)(((gridDim.x & 7u) == 0u) ? ((blockIdx.x & 7u) * (gridDim.x >> 3) + (blockIdx.x >> 3)) : blockIdx.x), (const char*)(c.ws + WS_ACT2), (const char*)(c.ws + WS_MDN), (unsigned)DFF, (unsigned)DFF, (size_t)2048 * DFF, nullptr};
                pg8::EpiMoeDown E{c.p<bf16_t>(WS_YR), c.p<float>(WS_ROWW), c.p<float>(WS_PART), {}}; pg8::gemm_phase<pg8::EpiMoeDown, MoeSched<false>, true>(greg, S, E, 44, (unsigned)DFF); } ENDPHASE
    PHASE(16) if (lo == 16) moe_tables(c, lds); p16_combine(c, lds); ENDPHASE
#if MK_LAST_PHASE < 17
    PHASE(17) if (MK_LAST_PHASE <= 7) dump_out(c); else copy_out(c, c.p<float>(MK_LAST_PHASE <= 4 ? WS_H1 : MK_LAST_PHASE <= 6 ? WS_H2 : WS_H3)); ENDPHASE
#endif
}

extern "C" void kernel_launch(void* const* d_in, const int* in_sizes, int n_in, void* d_out, int out_size, void* d_ws, size_t ws_size, hipStream_t stream) {
    static int grid = 0;
    if (grid == 0) {
        if (n_in != 29 || out_size != L * D || ws_size < WS_END) { fprintf(stderr, "kernel_launch: unexpected problem (n_in %d out %d ws %zu need %zu)\n", n_in, out_size, ws_size, (size_t)WS_END); grid = -1; return; }
        int dev = 0, cus = 0, per_cu = 0;
        if (hipGetDevice(&dev) != hipSuccess || hipDeviceGetAttribute(&cus, hipDeviceAttributeMultiprocessorCount, dev) != hipSuccess) { grid = -1; return; }
        if (hipFuncSetAttribute((const void*)fwd_kernel, hipFuncAttributeMaxDynamicSharedMemorySize, LDS_BYTES) != hipSuccess) { fprintf(stderr, "kernel_launch: hipFuncSetAttribute failed\n"); grid = -1; return; }
        if (hipOccupancyMaxActiveBlocksPerMultiprocessor(&per_cu, (const void*)fwd_kernel, 512, LDS_BYTES) != hipSuccess || per_cu < 1) { fprintf(stderr, "kernel_launch: occupancy query reports %d\n", per_cu); }
        (void)hipGetLastError();
        grid = cus;
    }
    if (grid < 0) return;
    (void)hipMemsetAsync((char*)d_ws + WS_CTL, 0, CTL_BYTES, stream);
    Args a{};
    for (int i = 0; i < 29; ++i) a.in[i] = (const float*)d_in[i];
    a.out = (float*)d_out; a.ws = (unsigned char*)d_ws;
    const int nph = (MK_LAST_PHASE < 17) ? 18 : 17;
#if MK_N_LAUNCHES == 1
    a.ph_lo = 0; a.ph_hi = nph;
    if (MK_LAST_PHASE < 17) {
        a.ph_lo = 0; a.ph_hi = MK_LAST_PHASE; hipLaunchKernelGGL(fwd_kernel, dim3(grid), dim3(512), LDS_BYTES, stream, a);
        a.ph_lo = 17; a.ph_hi = 18; hipLaunchKernelGGL(fwd_kernel, dim3(grid), dim3(512), LDS_BYTES, stream, a);
    } else hipLaunchKernelGGL(fwd_kernel, dim3(grid), dim3(512), LDS_BYTES, stream, a);
#else
    for (int ph = 0; ph < nph; ++ph) {
        if (ph >= MK_LAST_PHASE && ph < 17) continue;
        a.ph_lo = ph; a.ph_hi = ph + 1; hipLaunchKernelGGL(fwd_kernel, dim3(grid), dim3(512), LDS_BYTES, stream, a);
    }
#endif
    const hipError_t le = hipPeekAtLastError();
    if (le != hipSuccess) fprintf(stderr, "kernel_launch: launch failed: %s\n", hipGetErrorName(le));
}
```
